# Optimizing an MI355X kernel written in HIP

```python
import jax, jax.numpy as jnp
from jax import lax
import numpy as np

D_MODEL = 1024
BATCH = 4
SEQ = 4096
DEPTH = 1

D_MIX = D_MODEL
HG_WIDTH = D_MIX // 2
HG_HEADS = 4
HG_DK = HG_WIDTH // HG_HEADS
HG_DV = HG_WIDTH // HG_HEADS
HG_CHUNK = 64
POOL_WIDTH = D_MIX - HG_WIDTH
POOL_WINDOWS = (2, 4, 8, 16)
POOL_GROUPS = len(POOL_WINDOWS)
POOL_CG = POOL_WIDTH // POOL_GROUPS
IN_COLS = 4 * HG_WIDTH + POOL_WIDTH
N_EXPERTS = 64
TOP_K = 8
N_GROUP = 8
TOPK_GROUP = 4
D_EXPERT = 256
ROUTED_SCALE = 2.5
MOE_BLOCK = 128
LN_EPS = 1e-5
RMS_EPS = 1e-6
DEEPNORM_ALPHA = (2 * DEPTH) ** 0.25
DEEPNORM_BETA = (8 * DEPTH) ** -0.25

kernel_name = "hymba_hgrn2_pool_moe_deepnorm"


def layer_norm(x, g, b):
    xf = x.astype(jnp.float32)
    mu = xf.mean(-1, keepdims=True)
    var = jnp.square(xf - mu).mean(-1, keepdims=True)
    return ((xf - mu) * lax.rsqrt(var + LN_EPS) * g + b).astype(x.dtype)


def hgrn2_chunked(q, k, v, logf):
    B, S, H, DK = q.shape
    DV = v.shape[-1]
    NC = S // HG_CHUNK

    def to_chunks(t):
        return t.reshape(B, NC, HG_CHUNK, H, t.shape[-1]).transpose(1, 0, 3, 2, 4)

    qc, kc, vc, fc = (to_chunks(t) for t in (q, k, v, logf))
    causal = jnp.tril(jnp.ones((HG_CHUNK, HG_CHUNK), dtype=bool))[:, :, None]

    def step(state, inp):
        qb, kb, vb, fb = inp
        b = jnp.cumsum(fb, axis=2)
        o_inter = jnp.einsum('bhtk,bhkv->bhtv', qb * jnp.exp(b), state)
        diff = b[:, :, :, None, :] - b[:, :, None, :, :]
        decay = jnp.where(causal, jnp.exp(jnp.minimum(diff, 0.0)), 0.0)
        scores = jnp.einsum('bhtk,bhsk,bhtsk->bhts', qb, kb, decay)
        o_intra = jnp.einsum('bhts,bhsv->bhtv', scores, vb)
        b_last = b[:, :, -1:, :]
        k_dec = kb * jnp.exp(b_last - b)
        new_state = jnp.exp(b_last[:, :, 0, :])[..., None] * state + jnp.einsum('bhsk,bhsv->bhkv', k_dec, vb)
        return new_state, o_inter + o_intra

    s0 = jnp.zeros((B, H, DK, DV), jnp.float32)
    _, oc = lax.scan(step, s0, (qc, kc, vc, fc))
    return oc.transpose(1, 0, 3, 2, 4).reshape(B, S, H, DV)


def multiscale_pool(u, w_pool, pool_scale):
    B, S = u.shape[0], u.shape[1]
    uf = u.astype(jnp.float32)
    c = jnp.cumsum(uf, axis=1)
    pos = jnp.arange(1, S + 1, dtype=jnp.float32)
    outs = []
    for gi, w in enumerate(POOL_WINDOWS):
        cg = c[:, :, gi]
        prev = jnp.pad(cg, ((0, 0), (w, 0), (0, 0)))[:, :S]
        cnt = jnp.minimum(pos, float(w))[None, :, None]
        outs.append((cg - prev) / cnt - uf[:, :, gi])
    p = jnp.stack(outs, axis=2)
    p = jnp.einsum('bsgc,gcd->bsgd', p, w_pool.astype(jnp.float32))
    return (p.reshape(B, S, -1) * pool_scale).astype(u.dtype)


def hybrid_mixer(h, lb, w_in, hg_norm_g, w_pool, pool_scale, w_out):
    B, S, _ = h.shape
    proj = h @ w_in
    q, f_pre, i_v, g_out, u = jnp.split(proj, [HG_WIDTH, 2 * HG_WIDTH, 3 * HG_WIDTH, 4 * HG_WIDTH], axis=-1)
    f = lb + (1.0 - lb) * jax.nn.sigmoid(f_pre.astype(jnp.float32))
    k = 1.0 - f
    logf = jnp.log(f)
    qh = jax.nn.silu(q.astype(jnp.float32))
    shp = (B, S, HG_HEADS, HG_DK)
    o = hgrn2_chunked(qh.reshape(shp), k.reshape(shp), i_v.astype(jnp.float32).reshape(B, S, HG_HEADS, HG_DV), logf.reshape(shp))
    o = o * lax.rsqrt(jnp.mean(jnp.square(o), axis=-1, keepdims=True) + RMS_EPS)
    o = o.reshape(B, S, HG_WIDTH) * hg_norm_g * jax.nn.silu(g_out.astype(jnp.float32))
    p = multiscale_pool(u.reshape(B, S, POOL_GROUPS, POOL_CG), w_pool, pool_scale)
    mix = jnp.concatenate([o.astype(h.dtype), p], axis=-1)
    return mix @ w_out


def moe_ffn(h, w_router, router_bias, w_gate, w_up, w_down, ws_gate, ws_up, ws_down):
    B, S, D = h.shape
    T = B * S
    A = T * TOP_K
    NB = -(-(A + N_EXPERTS * (MOE_BLOCK - 1)) // MOE_BLOCK)
    xt = h.reshape(T, D)
    scores = jax.nn.sigmoid((xt @ w_router).astype(jnp.float32))
    sel = scores + router_bias.astype(jnp.float32)
    grp = sel.reshape(T, N_GROUP, N_EXPERTS // N_GROUP)
    grp_score = lax.top_k(grp, 2)[0].sum(-1)
    _, gidx = lax.top_k(grp_score, TOPK_GROUP)
    gmask = jax.nn.one_hot(gidx, N_GROUP, dtype=jnp.int32).sum(1) > 0
    emask = jnp.repeat(gmask, N_EXPERTS // N_GROUP, axis=1)
    _, eidx = lax.top_k(jnp.where(emask, sel, -jnp.inf), TOP_K)
    wts = jnp.take_along_axis(scores, eidx, axis=-1)
    wts = wts / wts.sum(-1, keepdims=True) * ROUTED_SCALE
    flat_e = eidx.reshape(A).astype(jnp.int32)
    flat_tok = jnp.repeat(jnp.arange(T, dtype=jnp.int32), TOP_K)
    flat_w = wts.reshape(A)
    order = jnp.argsort(flat_e, stable=True)
    se, stok, sw = flat_e[order], flat_tok[order], flat_w[order]
    counts = jnp.bincount(flat_e, length=N_EXPERTS)
    padded = ((counts + MOE_BLOCK - 1) // MOE_BLOCK) * MOE_BLOCK
    start = jnp.cumsum(counts) - counts
    pend = jnp.cumsum(padded)
    pstart = pend - padded
    dest = pstart[se] + (jnp.arange(A, dtype=jnp.int32) - start[se])
    tok_of_slot = jnp.full((NB * MOE_BLOCK,), T, dtype=jnp.int32).at[dest].set(stok)
    xpad = jnp.concatenate([xt, jnp.zeros((1, D), xt.dtype)], axis=0)
    xin = xpad[tok_of_slot].reshape(NB, MOE_BLOCK, D)
    blk_e = jnp.clip(jnp.searchsorted(pend, jnp.arange(NB) * MOE_BLOCK, side='right'), 0, N_EXPERTS - 1)

    def block_ffn(args):
        xb, e = args
        return (jax.nn.silu(xb @ w_gate[e]) * (xb @ w_up[e])) @ w_down[e]

    yb = lax.map(block_ffn, (xin, blk_e)).reshape(NB * MOE_BLOCK, D)
    y_assign = yb[dest] * sw[:, None].astype(yb.dtype)
    routed = jax.ops.segment_sum(y_assign, stok, num_segments=T)
    shared = (jax.nn.silu(xt @ ws_gate) * (xt @ ws_up)) @ ws_down
    return (routed + shared).reshape(B, S, D)


def setup_inputs(seed: int = 0) -> dict:
    key = jax.random.key(seed)
    ks = jax.random.split(key, 20)
    n = jax.random.normal
    f32 = jnp.float32
    col_scale = jnp.concatenate([
        jnp.ones((2 * HG_WIDTH,), f32), jnp.full((HG_WIDTH,), DEEPNORM_BETA, f32),
        jnp.ones((HG_WIDTH,), f32), jnp.full((POOL_WIDTH,), DEEPNORM_BETA, f32)])
    return {
        "x": n(ks[0], (BATCH, SEQ, D_MODEL), f32),
        "w_in": n(ks[1], (DEPTH, D_MODEL, IN_COLS), f32) * D_MODEL ** -0.5 * col_scale,
        "hg_lb_logits": n(ks[2], (DEPTH + 1, HG_WIDTH), f32) * 0.5,
        "hg_norm_g": 1.0 + 0.02 * n(ks[3], (DEPTH, HG_WIDTH), f32),
        "w_pool": n(ks[4], (DEPTH, POOL_GROUPS, POOL_CG, POOL_CG), f32) * POOL_CG ** -0.5 * DEEPNORM_BETA,
        "pool_scale": 1.0 + 0.02 * n(ks[5], (DEPTH, POOL_WIDTH), f32),
        "w_out": n(ks[6], (DEPTH, D_MIX, D_MODEL), f32) * D_MIX ** -0.5 * DEEPNORM_BETA,
        "ln1_g": 1.0 + 0.02 * n(ks[7], (DEPTH, D_MODEL), f32),
        "ln1_b": 0.02 * n(ks[8], (DEPTH, D_MODEL), f32),
        "w_router": n(ks[9], (DEPTH, D_MODEL, N_EXPERTS), f32) * D_MODEL ** -0.5,
        "router_bias": 0.01 * n(ks[10], (DEPTH, N_EXPERTS), f32),
        "w_gate": n(ks[11], (DEPTH, N_EXPERTS, D_MODEL, D_EXPERT), f32) * D_MODEL ** -0.5 * DEEPNORM_BETA,
        "w_up": n(ks[12], (DEPTH, N_EXPERTS, D_MODEL, D_EXPERT), f32) * D_MODEL ** -0.5 * DEEPNORM_BETA,
        "w_down": n(ks[13], (DEPTH, N_EXPERTS, D_EXPERT, D_MODEL), f32) * D_EXPERT ** -0.5 * DEEPNORM_BETA,
        "ws_gate": n(ks[14], (DEPTH, D_MODEL, D_EXPERT), f32) * D_MODEL ** -0.5 * DEEPNORM_BETA,
        "ws_up": n(ks[15], (DEPTH, D_MODEL, D_EXPERT), f32) * D_MODEL ** -0.5 * DEEPNORM_BETA,
        "ws_down": n(ks[16], (DEPTH, D_EXPERT, D_MODEL), f32) * D_EXPERT ** -0.5 * DEEPNORM_BETA,
        "ln2_g": 1.0 + 0.02 * n(ks[17], (DEPTH, D_MODEL), f32),
        "ln2_b": 0.02 * n(ks[18], (DEPTH, D_MODEL), f32),
    }


def reference(x, w_in, hg_lb_logits, hg_norm_g, w_pool, pool_scale, w_out, ln1_g, ln1_b,
              w_router, router_bias, w_gate, w_up, w_down, ws_gate, ws_up, ws_down, ln2_g, ln2_b):
    lower_bounds = jnp.cumsum(jax.nn.softmax(hg_lb_logits.astype(jnp.float32), axis=0), axis=0)
    h = x
    for layer in range(DEPTH):
        mix = hybrid_mixer(h, lower_bounds[layer], w_in[layer], hg_norm_g[layer], w_pool[layer],
                           pool_scale[layer], w_out[layer])
        h = layer_norm(DEEPNORM_ALPHA * h + mix, ln1_g[layer], ln1_b[layer])
        ffn = moe_ffn(h, w_router[layer], router_bias[layer], w_gate[layer], w_up[layer], w_down[layer],
                      ws_gate[layer], ws_up[layer], ws_down[layer])
        h = layer_norm(DEEPNORM_ALPHA * h + ffn, ln2_g[layer], ln2_b[layer])
    return h
```

```cpp
#include <hip/hip_runtime.h>
#include <cstdio>
#include <cstdint>

#ifndef OPT_MASK
#define OPT_MASK 0x1F
#endif
#ifndef FUSED
#define FUSED 0
#endif

constexpr int D_MODEL = 1024, BATCH = 4, SEQ = 4096, T_TOK = BATCH * SEQ;
constexpr int HG_W = 512, HG_H = 4, HG_D = 128;
constexpr int POOL_W = 512, POOL_G = 4, POOL_CG = 128;
constexpr int IN_COLS = 2560;
constexpr int N_EXP = 64, TOP_K = 8, N_GRP = 8, D_EXP = 256;
constexpr float ROUTED_SCALE = 2.5f, LN_EPS = 1e-5f, RMS_EPS = 1e-6f;
constexpr float DN_ALPHA = 1.18920711500272106672f;
constexpr int HALF_TOK = T_TOK / 2, NGROUP = 130, GCAP = 8192;

typedef unsigned short bf16_t;
__device__ __forceinline__ unsigned f2bf(float f) { unsigned u = __builtin_bit_cast(unsigned, f); return (u + 0x7fffu + ((u >> 16) & 1u)) >> 16; }
__device__ __forceinline__ float bf2f(unsigned h) { return __builtin_bit_cast(float, h << 16); }
__device__ __forceinline__ float sigmoidf_(float x) { return 1.0f / (1.0f + __expf(-x)); }
__device__ __forceinline__ float siluf_(float x) { return x / (1.0f + __expf(-x)); }
__device__ __forceinline__ float wave_sum(float v) {
#pragma unroll
    for (int o = 1; o < 64; o <<= 1) v += __shfl_xor(v, o);
    return v;
}

constexpr size_t MiB = 1u << 20;
constexpr size_t WS_CTL = 0;
constexpr size_t WS_SMALL = 1 * MiB;
constexpr size_t WS_GDEC = 1 * MiB + 64 * 1024;
constexpr size_t WS_WP_T = 1 * MiB + 640 * 1024, WS_WR_HI = 1 * MiB + 768 * 1024, WS_WR_LO = 1 * MiB + 896 * 1024;
constexpr size_t WS_WIN_T = 2 * MiB, WS_WOUT_T = 7 * MiB;
constexpr size_t WS_ROUTE = 9 * MiB;
constexpr size_t WS_XB = 16 * MiB, WS_US = 16 * MiB;
constexpr size_t WS_Q = 48 * MiB, WS_V = 64 * MiB, WS_GS = 80 * MiB, WS_UU = 96 * MiB, WS_LOGF = 112 * MiB, WS_MIX = 144 * MiB;
constexpr size_t WS_TMP0 = 176 * MiB, WS_TMP1 = 208 * MiB;
constexpr size_t WS_WD_T = 20 * MiB;
constexpr size_t WS_ACT = 53 * MiB;
constexpr size_t WS_YB = 142 * MiB;
constexpr size_t WS_WGU_T = 142 * MiB;
constexpr size_t WS_HB = 207 * MiB;
constexpr size_t WS_NEED = 270 * MiB;
constexpr size_t RT_ASG_E = 0;
constexpr size_t RT_ASG_W = RT_ASG_E + (size_t)T_TOK * 8 * 4;
constexpr size_t RT_ASG_S = RT_ASG_W + (size_t)T_TOK * 8 * 4;
constexpr size_t RT_LIST = RT_ASG_S + (size_t)T_TOK * 8 * 4;
constexpr size_t RT_WLIST = RT_LIST + (size_t)NGROUP * GCAP * 4;
static_assert(WS_ROUTE + RT_WLIST + (size_t)NGROUP * GCAP * 4 <= WS_WD_T, "route tables");
constexpr int CW_GCOUNT = 1024;
constexpr int CW_BAR = 4096;

template <bool ABF16>
__global__ void __launch_bounds__(256) nv_gemm(const void* Av, int lda, const float* B, int ldb, float* C, int ldc, int M, int N, int K, const float* R, float alphaR) {
    __shared__ float As[16][64 + 1], Bs[16][64 + 1];
    const int tx = threadIdx.x & 15, ty = threadIdx.x >> 4, m0 = blockIdx.y * 64, n0 = blockIdx.x * 64;
    float acc[4][4];
#pragma unroll
    for (int i = 0; i < 4; ++i)
#pragma unroll
        for (int j = 0; j < 4; ++j) acc[i][j] = 0.f;
    for (int k0 = 0; k0 < K; k0 += 16) {
#pragma unroll
        for (int i = 0; i < 4; ++i) {
            const int idx = threadIdx.x + i * 256, r = idx >> 4, c = idx & 15;
            float a;
            if (ABF16) a = bf2f(((const bf16_t*)Av)[(size_t)(m0 + r) * lda + k0 + c]); else a = ((const float*)Av)[(size_t)(m0 + r) * lda + k0 + c];
            As[c][r] = a;
            const int rb = idx >> 6, cb = idx & 63;
            Bs[rb][cb] = B[(size_t)(k0 + rb) * ldb + n0 + cb];
        }
        __syncthreads();
#pragma unroll
        for (int k = 0; k < 16; ++k) {
            float a[4], b[4];
#pragma unroll
            for (int i = 0; i < 4; ++i) { a[i] = As[k][ty * 4 + i]; b[i] = Bs[k][tx * 4 + i]; }
#pragma unroll
            for (int i = 0; i < 4; ++i)
#pragma unroll
                for (int j = 0; j < 4; ++j) acc[i][j] += a[i] * b[j];
        }
        __syncthreads();
    }
#pragma unroll
    for (int i = 0; i < 4; ++i)
#pragma unroll
        for (int j = 0; j < 4; ++j) {
            const size_t o = (size_t)(m0 + ty * 4 + i) * ldc + n0 + tx * 4 + j;
            float v = acc[i][j];
            if (R) v += alphaR * R[o];
            C[o] = v;
        }
}

__global__ void nv_lb(const float* lg, float* lb) {
    const int c = blockIdx.x * blockDim.x + threadIdx.x;
    if (c < HG_W) { const float a = lg[c], b = lg[HG_W + c], m = fmaxf(a, b); const float ea = expf(a - m), eb = expf(b - m); lb[c] = ea / (ea + eb); }
}

__global__ void nv_act(const float* P, int sec, const float* lb, bf16_t* Q, float* LOGF, bf16_t* V, bf16_t* GS, bf16_t* UU) {
    const size_t i = (size_t)blockIdx.x * blockDim.x + threadIdx.x;
    if (i >= (size_t)T_TOK * 512) return;
    const int c = (int)(i & 511);
    const float p = P[i];
    if (sec == 0) Q[i] = (bf16_t)f2bf(siluf_(p));
    else if (sec == 1) { const float l = lb[c]; const float f = l + (1.0f - l) * sigmoidf_(p); LOGF[i] = logf(f); }
    else if (sec == 2) V[i] = (bf16_t)f2bf(p);
    else if (sec == 3) GS[i] = (bf16_t)f2bf(siluf_(p));
    else UU[i] = (bf16_t)f2bf(p);
}

__global__ void __launch_bounds__(128) nv_hgrn(const bf16_t* Q, const float* LOGF, const bf16_t* V, float* O) {
    __shared__ float sf[128], sk[128], sq[128];
    const int b = blockIdx.x / HG_H, h = blockIdx.x % HG_H, v = threadIdx.x;
    float S[128];
#pragma unroll
    for (int k = 0; k < 128; ++k) S[k] = 0.f;
    for (int t = 0; t < SEQ; ++t) {
        const size_t row = (size_t)(b * SEQ + t) * HG_W + h * HG_D;
        const float f = expf(LOGF[row + v]);
        sf[v] = f; sk[v] = 1.0f - f; sq[v] = bf2f(Q[row + v]);
        const float vv = bf2f(V[row + v]);
        __syncthreads();
        float o = 0.f;
#pragma unroll
        for (int k = 0; k < 128; ++k) { S[k] = sf[k] * S[k] + sk[k] * vv; o += S[k] * sq[k]; }
        O[row + v] = o;
        __syncthreads();
    }
}
__global__ void __launch_bounds__(256) nv_hgnorm(const float* O, const float* ng, const bf16_t* GS, bf16_t* MIX) {
    const int w = (blockIdx.x * 256 + threadIdx.x) >> 6, lane = threadIdx.x & 63;
    const int t = w / HG_H, h = w % HG_H;
    if (t >= T_TOK) return;
    const size_t row = (size_t)t * HG_W + h * HG_D;
    const float a = O[row + lane], c = O[row + 64 + lane];
    const float ss = wave_sum(a * a + c * c);
    const float r = 1.0f / sqrtf(ss * (1.0f / 128.0f) + RMS_EPS);
    MIX[(size_t)t * D_MODEL + h * HG_D + lane] = (bf16_t)f2bf(a * r * ng[h * HG_D + lane] * bf2f(GS[row + lane]));
    MIX[(size_t)t * D_MODEL + h * HG_D + 64 + lane] = (bf16_t)f2bf(c * r * ng[h * HG_D + 64 + lane] * bf2f(GS[row + 64 + lane]));
}
__global__ void nv_pool(const bf16_t* UU, float* P) {
    const size_t i = (size_t)blockIdx.x * blockDim.x + threadIdx.x;
    if (i >= (size_t)T_TOK * 512) return;
    const int col = (int)(i & 511), t = (int)(i >> 9), g = col >> 7, pos = t % SEQ, w = 2 << g;
    float s = 0.f;
    for (int r = 0; r < w; ++r) if (pos - r >= 0) s += bf2f(UU[(size_t)(t - r) * 512 + col]);
    const float cnt = (float)(pos + 1 < w ? pos + 1 : w);
    P[i] = s / cnt - bf2f(UU[i]);
}
__global__ void nv_poolout(const float* PM, const float* ps, bf16_t* MIX) {
    const size_t i = (size_t)blockIdx.x * blockDim.x + threadIdx.x;
    if (i >= (size_t)T_TOK * 512) return;
    const int col = (int)(i & 511), t = (int)(i >> 9);
    MIX[(size_t)t * D_MODEL + 512 + col] = (bf16_t)f2bf(PM[i] * ps[col]);
}

__global__ void __launch_bounds__(64) nv_ln_route(float* Y, const float* g1, const float* b1, const float* wr, const float* rb, bf16_t* HB,
                                                  int* asg_e, float* asg_w, int* asg_s, int* list, float* wlist, unsigned* gcount) {
    __shared__ float hs[D_MODEL];
    const int t = blockIdx.x, lane = threadIdx.x;
    float* y = Y + (size_t)t * D_MODEL;
    float v[16]; float s = 0.f;
#pragma unroll
    for (int j = 0; j < 16; ++j) { v[j] = y[lane + 64 * j]; s += v[j]; }
    const float mu = wave_sum(s) * (1.0f / D_MODEL);
    float q = 0.f;
#pragma unroll
    for (int j = 0; j < 16; ++j) { const float d = v[j] - mu; q += d * d; }
    const float rstd = 1.0f / sqrtf(wave_sum(q) * (1.0f / D_MODEL) + LN_EPS);
#pragma unroll
    for (int j = 0; j < 16; ++j) { const int c = lane + 64 * j; const float h = (v[j] - mu) * rstd * g1[c] + b1[c]; hs[c] = h; y[c] = DN_ALPHA * h; HB[(size_t)t * D_MODEL + c] = (bf16_t)f2bf(h); }
    __syncthreads();
    float lg = 0.f;
    for (int k = 0; k < D_MODEL; ++k) lg += hs[k] * wr[k * N_EXP + lane];
    const float score = 1.0f / (1.0f + expf(-lg));
    const float sel = score + rb[lane];
    int rk = 0;
#pragma unroll
    for (int o = 1; o < 8; ++o) { const int src = (lane & ~7) | ((lane + o) & 7); const float x = __shfl(sel, src); rk += (x > sel || (x == sel && src < lane)) ? 1 : 0; }
    float gsum = rk < 2 ? sel : 0.f;
    gsum += __shfl_xor(gsum, 1); gsum += __shfl_xor(gsum, 2); gsum += __shfl_xor(gsum, 4);
    const int grp = lane >> 3; int grk = 0;
#pragma unroll
    for (int o = 1; o < 8; ++o) { const int sg = (grp + o) & 7; const float x = __shfl(gsum, sg * 8); grk += (x > gsum || (x == gsum && sg < grp)) ? 1 : 0; }
    const bool gsel = grk < 4;
    const float msel = gsel ? sel : -INFINITY;
    int erk = 0;
    for (int o = 1; o < 64; ++o) { const int src = (lane + o) & 63; const float x = __shfl(msel, src); erk += (x > msel || (x == msel && src < lane)) ? 1 : 0; }
    const bool chosen = gsel && erk < 8;
    const float wsum = wave_sum(chosen ? score : 0.f);
    if (chosen) {
        const int half = t >= (T_TOK / 2) ? 1 : 0, grpid = half * 65 + lane;
        const unsigned slot = atomicAdd(&gcount[grpid], 1u);
        asg_e[t * 8 + erk] = lane; asg_w[t * 8 + erk] = score / wsum * ROUTED_SCALE; asg_s[t * 8 + erk] = (int)slot;
        list[(size_t)grpid * 8192 + slot] = t; wlist[(size_t)grpid * 8192 + slot] = score / wsum * ROUTED_SCALE;
    }
}

__global__ void __launch_bounds__(256) nv_moe(float* Y, const int* asg_e, const float* asg_w, const float* wg, const float* wu, const float* wd,
                                              const float* sg, const float* su, const float* sd, const float* g2, const float* b2) {
    __shared__ float xs[D_MODEL], act[D_EXP], red[8];
    const int t = blockIdx.x, n = threadIdx.x, lane = n & 63, wid = n >> 6;
    float* y = Y + (size_t)t * D_MODEL;
    float tot[4];
#pragma unroll
    for (int j = 0; j < 4; ++j) { tot[j] = y[n + 256 * j]; xs[n + 256 * j] = tot[j] * (1.0f / DN_ALPHA); }
    __syncthreads();
    for (int k = 0; k < 9; ++k) {
        const float* G; const float* U; const float* Dn; float w;
        if (k < 8) { const int e = asg_e[t * 8 + k]; w = asg_w[t * 8 + k]; G = wg + (size_t)e * D_MODEL * D_EXP; U = wu + (size_t)e * D_MODEL * D_EXP; Dn = wd + (size_t)e * D_EXP * D_MODEL; }
        else { w = 1.0f; G = sg; U = su; Dn = sd; }
        float a = 0.f, b = 0.f;
        for (int kk = 0; kk < D_MODEL; ++kk) { const float x = xs[kk]; a += x * G[(size_t)kk * D_EXP + n]; b += x * U[(size_t)kk * D_EXP + n]; }
        act[n] = siluf_(a) * b;
        __syncthreads();
        float o[4] = {0.f, 0.f, 0.f, 0.f};
        for (int j = 0; j < D_EXP; ++j) { const float aj = act[j];
#pragma unroll
            for (int c = 0; c < 4; ++c) o[c] += aj * Dn[(size_t)j * D_MODEL + n + 256 * c]; }
#pragma unroll
        for (int c = 0; c < 4; ++c) tot[c] += w * o[c];
        __syncthreads();
    }
    float s = (tot[0] + tot[1]) + (tot[2] + tot[3]);
    s = wave_sum(s); if (lane == 0) red[wid] = s;
    __syncthreads();
    const float mu = (red[0] + red[1] + red[2] + red[3]) * (1.0f / D_MODEL);
    float q = 0.f;
#pragma unroll
    for (int c = 0; c < 4; ++c) { const float d = tot[c] - mu; q += d * d; }
    q = wave_sum(q); if (lane == 0) red[4 + wid] = q;
    __syncthreads();
    const float rstd = 1.0f / sqrtf((red[4] + red[5] + red[6] + red[7]) * (1.0f / D_MODEL) + LN_EPS);
#pragma unroll
    for (int c = 0; c < 4; ++c) { const int col = n + 256 * c; y[col] = (tot[c] - mu) * rstd * g2[col] + b2[col]; }
}

#define LAS __attribute__((address_space(3)))
#define GAS __attribute__((address_space(1)))
typedef short bf16x8 __attribute__((ext_vector_type(8)));
typedef float f32x4 __attribute__((ext_vector_type(4)));
typedef float f32x2 __attribute__((ext_vector_type(2)));
typedef unsigned u32x4 __attribute__((ext_vector_type(4)));
typedef unsigned u32x2 __attribute__((ext_vector_type(2)));
typedef GAS unsigned gu32;
#define RLX_AGENT __ATOMIC_RELAXED, __HIP_MEMORY_SCOPE_AGENT
#define LDS_WAIT() asm volatile("s_waitcnt lgkmcnt(0)" ::: "memory")
#define VM_WAIT() asm volatile("s_waitcnt vmcnt(0)" ::: "memory")
__device__ __forceinline__ unsigned cvt_pk_bf16(float lo, float hi) { unsigned r; asm volatile("v_cvt_pk_bf16_f32 %0, %1, %2" : "=v"(r) : "v"(lo), "v"(hi)); return r; }
__device__ __forceinline__ f32x4 ld4(const float* p) { return *(const f32x4*)p; }

constexpr int NWAVES = 8, NTHREADS = 512;
constexpr int LDS_BYTES = 160 * 1024;
constexpr int LDSCTL_OFF = LDS_BYTES - 16384;
constexpr int MISC_OFF = LDSCTL_OFF + 320;
constexpr int TAB_OFF = LDSCTL_OFF + 1024;
constexpr int TAB_CNT = TAB_OFF, TAB_TBASE = TAB_OFF + 576, TAB_CBASE = TAB_OFF + 1152, TAB_T2G = TAB_OFF + 1728;
static_assert(TAB_T2G + 768 <= LDS_BYTES, "LDS map");

namespace pg8 {
constexpr int BM = 256, BK = 64, HALF = 128, HTB = HALF * BK * 2, STAGE_BYTES = 8 * HTB, NXCD = 8, WGM = 8;
__host__ __device__ __forceinline__ int lds_byte(int r, int c) { const int st = (r >> 4) * 2 + (c >> 5), rr = r & 15, cc = c & 31, ob = rr * 64 + cc * 2; return st * 1024 + (ob ^ (((ob >> 9) & 1) << 5)); }
__host__ __device__ __forceinline__ void stage_rc(int b, int& R, int& C) { const int st = b / 1024, sb = b % 1024, swz = sb ^ (((sb >> 9) & 1) << 5); R = (st >> 1) * 16 + swz / 64; C = (st & 1) * 32 + (swz % 64) / 2; }
__host__ __device__ __forceinline__ int perm32(int rho) { const int n = rho >> 4, i = rho & 15; return 8 * (i >> 2) + 4 * n + (i & 3); }

struct Unit { int pm, pn, g; };

template <class Epi, class Sched, bool ALIGN_EPI>
__device__ __forceinline__ void gemm_phase(LAS unsigned char* lds, const char* Abase, const int K, const Sched& S, const Epi& E) {
    const int tid = threadIdx.x, wid = __builtin_amdgcn_readfirstlane(tid >> 6), lane = tid & 63, wr = wid >> 2, wc = wid & 3, fr = lane & 15, fq = lane >> 4;
    const int nt = K / BK;
    int Rs[2], Cs[2]; unsigned voffB[2];
#pragma unroll
    for (int i = 0; i < 2; ++i) { int R, C; stage_rc(tid * 16 + i * 8192, R, C); Rs[i] = R; Cs[i] = C; const int Rb = Epi::PERM ? ((R & ~31) + perm32(R & 31)) : R; voffB[i] = (unsigned)(Rb * K + C) * 2u; }
    const size_t kstep = (size_t)(BK * 2);
    const size_t hstep = (size_t)HALF * K * 2;
    const unsigned ldsw = (unsigned)wid * 1024u;
    const int aoff = lds_byte(wr * 64 + fr, fq * 8), boff = lds_byte(wc * 32 + fr, fq * 8);
#define PG8_SA(b, h) (((b) * 2 + (h)) * HTB)
#define PG8_SB(b, h) ((4 + (b) * 2 + (h)) * HTB)
#define PG8_STAGE_B(bufoff, gbase) do { _Pragma("unroll") for (int _i = 0; _i < 2; ++_i) \
        __builtin_amdgcn_global_load_lds((const unsigned*)((const char*)(gbase) + voffB[_i]), (LAS unsigned*)(lds + (bufoff) + ldsw + _i * 8192), 16, 0, 0); } while (0)
#define PG8_STAGE_A(bufoff, kbyte, vo) do { _Pragma("unroll") for (int _i = 0; _i < 2; ++_i) \
        __builtin_amdgcn_global_load_lds((const unsigned*)(Abase + (size_t)(kbyte) + (vo)[_i]), (LAS unsigned*)(lds + (bufoff) + ldsw + _i * 8192), 16, 0, 0); } while (0)
#define PG8_LDA(dst, b, h) do { _Pragma("unroll") for (int m = 0; m < 4; ++m) _Pragma("unroll") for (int k = 0; k < 2; ++k) dst[m][k] = *(const LAS bf16x8*)(lds + PG8_SA(b, h) + aoff + m * 2048 + k * 1024); } while (0)
#define PG8_LDB(dst, b, h) do { _Pragma("unroll") for (int n = 0; n < 2; ++n) _Pragma("unroll") for (int k = 0; k < 2; ++k) dst[n][k] = *(const LAS bf16x8*)(lds + PG8_SB(b, h) + boff + n * 2048 + k * 1024); } while (0)
#define PG8_MMA(ai, bj, At, Bt) do { __builtin_amdgcn_s_setprio(1); _Pragma("unroll") for (int m = 0; m < 4; ++m) _Pragma("unroll") for (int n = 0; n < 2; ++n) _Pragma("unroll") for (int k = 0; k < 2; ++k) \
        acc[ai][bj][m][n] = __builtin_amdgcn_mfma_f32_16x16x32_bf16(Bt[n][k], At[m][k], acc[ai][bj][m][n], 0, 0, 0); __builtin_amdgcn_s_setprio(0); } while (0)
#define PG8_WAIT_V(n) asm volatile("s_waitcnt vmcnt(" #n ")" ::: "memory")
#define PG8_WAIT_L(n) asm volatile("s_waitcnt lgkmcnt(" #n ")" ::: "memory")
#define PG8_BAR __builtin_amdgcn_s_barrier()
#define PG8_SCHED __builtin_amdgcn_sched_barrier(0)
    Unit cur, nxt; int ui = 0;
    if (!S.next(0, cur)) return;
    f32x4 acc[2][2][4][2];
#pragma unroll
    for (int a = 0; a < 2; ++a)
#pragma unroll
        for (int b = 0; b < 2; ++b)
#pragma unroll
            for (int m = 0; m < 4; ++m)
#pragma unroll
                for (int n = 0; n < 2; ++n) acc[a][b][m][n] = (f32x4){0.f, 0.f, 0.f, 0.f};
    bf16x8 At[4][2], B0[2][2], B1[2][2];
    unsigned vc[2][2], vn[2][2];
    S.rowsA(cur, Rs, Cs, vc);
    const char* cB = S.ptrB(cur);
    PG8_STAGE_B(PG8_SB(0, 0), cB); PG8_STAGE_B(PG8_SB(0, 1), cB + hstep); PG8_STAGE_A(PG8_SA(0, 0), 0, vc[0]); PG8_STAGE_A(PG8_SA(0, 1), 0, vc[1]);
    if (wr == 1) PG8_BAR;
    PG8_WAIT_V(2); PG8_BAR;
    PG8_STAGE_B(PG8_SB(1, 0), cB + kstep); PG8_STAGE_A(PG8_SA(1, 0), kstep, vc[0]); PG8_STAGE_B(PG8_SB(1, 1), cB + hstep + kstep);
    PG8_WAIT_V(6); PG8_BAR;
    for (;;) {
        const bool has_next = S.next(ui + 1, nxt);
        const char* nB = cB;
        if (has_next) { S.rowsA(nxt, Rs, Cs, vn); nB = S.ptrB(nxt); }
        else {
#pragma unroll
            for (int h = 0; h < 2; ++h)
#pragma unroll
                for (int i = 0; i < 2; ++i) vn[h][i] = vc[h][i];
        }
#pragma unroll 1
        for (int t = 0; t < nt; t += 2) {
            const bool last = (t == nt - 2);
            const size_t a1k = (size_t)(t + 1) * kstep;
            const size_t a2k = last ? 0 : (size_t)(t + 2) * kstep;
            unsigned s2[2][2];
#pragma unroll
            for (int h = 0; h < 2; ++h)
#pragma unroll
                for (int i = 0; i < 2; ++i) s2[h][i] = last ? vn[h][i] : vc[h][i];
            const char* b2 = last ? nB : cB + (size_t)(t + 2) * kstep;
            const char* b3 = b2 + kstep;
            PG8_LDB(B0, 0, 0); PG8_LDB(B1, 0, 1); PG8_SCHED; PG8_LDA(At, 0, 0); PG8_STAGE_A(PG8_SA(1, 1), a1k, vc[1]);
            PG8_WAIT_V(8); PG8_WAIT_L(0); PG8_BAR; PG8_MMA(0, 0, At, B0); PG8_MMA(0, 1, At, B1); PG8_BAR; PG8_SCHED;
            PG8_LDA(At, 0, 1); PG8_STAGE_B(PG8_SB(0, 0), b2); PG8_STAGE_B(PG8_SB(0, 1), b2 + hstep); PG8_STAGE_A(PG8_SA(0, 0), a2k, s2[0]);
            PG8_WAIT_V(8); PG8_WAIT_L(0); PG8_BAR; PG8_MMA(1, 0, At, B0); PG8_MMA(1, 1, At, B1); PG8_BAR; PG8_SCHED;
            PG8_LDB(B0, 1, 0); PG8_LDB(B1, 1, 1); PG8_SCHED; PG8_LDA(At, 1, 0); PG8_STAGE_A(PG8_SA(0, 1), a2k, s2[1]);
            PG8_WAIT_V(8); PG8_WAIT_L(0); PG8_BAR; PG8_MMA(0, 0, At, B0); PG8_MMA(0, 1, At, B1); PG8_BAR; PG8_SCHED;
            PG8_LDA(At, 1, 1); PG8_STAGE_B(PG8_SB(1, 0), b3); PG8_STAGE_B(PG8_SB(1, 1), b3 + hstep); PG8_STAGE_A(PG8_SA(1, 0), a2k + kstep, s2[0]);
            PG8_WAIT_V(8); PG8_WAIT_L(0); PG8_BAR; PG8_MMA(1, 0, At, B0); PG8_MMA(1, 1, At, B1); PG8_BAR; PG8_SCHED;
        }
        if constexpr (ALIGN_EPI) { if (wr == 0) PG8_BAR; }
        E(acc, cur, wr, wc, fr, fq);
        if (!has_next) break;
#pragma unroll
        for (int a = 0; a < 2; ++a)
#pragma unroll
            for (int b = 0; b < 2; ++b)
#pragma unroll
                for (int m = 0; m < 4; ++m)
#pragma unroll
                    for (int n = 0; n < 2; ++n) acc[a][b][m][n] = (f32x4){0.f, 0.f, 0.f, 0.f};
        cur = nxt; cB = nB; ++ui;
#pragma unroll
        for (int h = 0; h < 2; ++h)
#pragma unroll
            for (int i = 0; i < 2; ++i) vc[h][i] = vn[h][i];
        if constexpr (ALIGN_EPI) { if (wr == 1) PG8_BAR; }
    }
    PG8_WAIT_V(0);
    if constexpr (!ALIGN_EPI) { if (wr == 0) PG8_BAR; }
    PG8_BAR;
#undef PG8_SA
#undef PG8_SB
#undef PG8_STAGE_A
#undef PG8_STAGE_B
#undef PG8_LDA
#undef PG8_LDB
#undef PG8_MMA
#undef PG8_WAIT_V
#undef PG8_WAIT_L
#undef PG8_BAR
#undef PG8_SCHED
}
}

#define XB_TMO      128
#define XB_XCNT(j)  (256  + 64 * (j))
#define XB_XSUB(j)  (1280 + 64 * (j))
#define XB_XGEN(j)  (2304 + 64 * (j))
#define XB_TOP      3328
#define XB_TOPGEN   3392
#define XCD_BAR_WORDS 3456
#define XB_SPIN_CAP (1u << 20)
__device__ __forceinline__ unsigned xb_ld(unsigned* p)              { return __hip_atomic_load(p, __ATOMIC_RELAXED, __HIP_MEMORY_SCOPE_AGENT); }
__device__ __forceinline__ unsigned xb_add(unsigned* p, unsigned v) { return __hip_atomic_fetch_add(p, v, __ATOMIC_RELAXED, __HIP_MEMORY_SCOPE_AGENT); }
__device__ __forceinline__ unsigned xb_xcc_id() { return (unsigned)__builtin_amdgcn_s_getreg((3 << 11) | 20) & 0xFu; }
#define XB_SPIN(cond, bar) do { unsigned _sp = 0; while (cond) { __builtin_amdgcn_s_sleep(1); \
    if ((++_sp & 255u) == 0u) { if (xb_ld(&(bar)[XB_TMO])) break; if (_sp > XB_SPIN_CAP) { atomicAdd(&(bar)[XB_TMO], 1u); break; } } } } while (0)
struct XcdBarrier { unsigned* bar; unsigned x; volatile LAS unsigned* st; };
__device__ __forceinline__ XcdBarrier xcd_barrier_post(unsigned* bar, volatile LAS unsigned* st) {
    XcdBarrier b; b.bar = bar; b.x = xb_xcc_id(); b.st = st;
    if (threadIdx.x == 0) (void)xb_add(&bar[XB_XCNT(b.x)], 1u);
    return b;
}
__device__ __forceinline__ void xcd_barrier_complete(unsigned* bar, unsigned x, unsigned& nloc, unsigned& nx) {
    const unsigned G = gridDim.x * gridDim.y * gridDim.z;
    unsigned sum, cnt, mine, sp = 0u;
    for (;;) {
        sum = 0u; cnt = 0u; mine = 0u;
#pragma unroll
        for (unsigned j = 0; j < 16; ++j) { const unsigned c = xb_ld(&bar[XB_XCNT(j)]); sum += c; cnt += (c > 0u) ? 1u : 0u; mine = (j == x) ? c : mine; }
        if (sum == G) break;
        __builtin_amdgcn_s_sleep(1);
        if ((++sp & 255u) == 0u) { if (xb_ld(&bar[XB_TMO])) break; if (sp > XB_SPIN_CAP) { atomicAdd(&bar[XB_TMO], 1u); break; } }
    }
    nloc = mine > 0u ? mine : 1u; nx = cnt > 0u ? cnt : 1u;
}
__device__ __forceinline__ void xcd_barrier(const XcdBarrier& b) {
    asm volatile("s_waitcnt vmcnt(0)" ::: "memory");
    __syncthreads();
    if (threadIdx.x == 0) {
        unsigned* bar = b.bar;
        __builtin_amdgcn_s_waitcnt(0);
        unsigned nloc = b.st[0], nx = b.st[1];
        if (nloc == 0u) { xcd_barrier_complete(bar, b.x, nloc, nx); b.st[0] = nloc; b.st[1] = nx; }
        const unsigned old = xb_add(&bar[XB_XSUB(b.x)], 1u);
        const unsigned gen = old / nloc;
        if (old + 1u == (gen + 1u) * nloc) {
            __builtin_amdgcn_fence(__ATOMIC_RELEASE, "agent");
            asm volatile("s_waitcnt vmcnt(0)" ::: "memory");
            const unsigned og = xb_add(&bar[XB_TOP], 1u);
            const unsigned tg = og / nx;
            if (og + 1u == (tg + 1u) * nx) xb_add(&bar[XB_TOPGEN], 1u);
            else XB_SPIN(xb_ld(&bar[XB_TOPGEN]) == tg, bar);
            __builtin_amdgcn_fence(__ATOMIC_ACQUIRE, "agent");
            xb_add(&bar[XB_XGEN(b.x)], 1u);
            asm volatile("s_waitcnt vmcnt(0)" ::: "memory");
        } else {
            XB_SPIN(xb_ld(&bar[XB_XGEN(b.x)]) == gen, bar);
            __builtin_amdgcn_fence(__ATOMIC_ACQUIRE, "agent");
            asm volatile("s_waitcnt vmcnt(0)" ::: "memory");
        }
    }
    __syncthreads();
}

struct Args { const float* in[19]; float* out; unsigned char* ws; int ph_lo, ph_hi, flags, pad; };
struct Frame {
    LAS unsigned char* lds; gu32* ctl; int tid, lane, wave, vcu, G;
    const float *x, *w_in, *lb_logits, *hg_norm_g, *w_pool, *pool_scale, *w_out, *ln1_g, *ln1_b, *w_router, *router_bias, *w_gate, *w_up, *w_down, *ws_gate, *ws_up, *ws_down, *ln2_g, *ln2_b;
    float* out; unsigned char* ws;
    float* LB; float* GDEC; bf16_t *WP_T, *WR_HI, *WR_LO, *WIN_T, *WOUT_T, *XB, *US, *Q, *V, *GS, *UU, *MIX, *WD_T, *ACT, *YB, *WGU_T, *HB; float* LOGF;
    int* asg_e; float* asg_w; int* asg_s; int* list; float* wlist;
};

__device__ __forceinline__ void transpose_item(const float* W, int K, int N, int k0, int n0, bf16_t* WT, int drow0, bf16_t* WL, LAS float* scr, int lane) {
#pragma unroll 8
    for (int i = 0; i < 32; ++i) { const int kk = 2 * i + (lane >> 5); scr[kk * 33 + (lane & 31)] = W[(size_t)(k0 + kk) * N + n0 + (lane & 31)]; }
    LDS_WAIT(); asm volatile("" ::: "memory");
    const int c = lane & 7;
#pragma unroll
    for (int j = 0; j < 4; ++j) { const int n = (lane >> 3) + 8 * j; const LAS float* s = scr + (8 * c) * 33 + n;
        float v[8];
#pragma unroll
        for (int q = 0; q < 8; ++q) v[q] = s[q * 33];
        u32x4 o; o.x = f2bf(v[0]) | (f2bf(v[1]) << 16); o.y = f2bf(v[2]) | (f2bf(v[3]) << 16); o.z = f2bf(v[4]) | (f2bf(v[5]) << 16); o.w = f2bf(v[6]) | (f2bf(v[7]) << 16);
        *(u32x4*)(WT + (size_t)(drow0 + n) * K + k0 + 8 * c) = o;
        if (WL) { float r[8];
#pragma unroll
            for (int q = 0; q < 8; ++q) r[q] = v[q] - bf2f(f2bf(v[q]));
            u32x4 p; p.x = f2bf(r[0]) | (f2bf(r[1]) << 16); p.y = f2bf(r[2]) | (f2bf(r[3]) << 16); p.z = f2bf(r[4]) | (f2bf(r[5]) << 16); p.w = f2bf(r[6]) | (f2bf(r[7]) << 16);
            *(u32x4*)(WL + (size_t)(drow0 + n) * K + k0 + 8 * c) = p; } }
    LDS_WAIT(); asm volatile("" ::: "memory");
}
__device__ __forceinline__ void p0_prep(Frame& F) {
    LAS float* scr = (LAS float*)(F.lds + F.wave * 16384);
    const int gw = F.vcu * NWAVES + F.wave, NGW = F.G * NWAVES;
    constexpr int I_IN = 16 * 80, I_OUT = 16 * 32, I_POOL = 4 * 2 * 4, I_R = 16 * 2;
    constexpr int NITEMS = I_IN + I_OUT + I_POOL + I_R;
    for (int it = gw; it < NITEMS; it += NGW) {
        int r = it;
        if (r < I_IN) { const int kb = r / 80, nb = r % 80; transpose_item(F.w_in, D_MODEL, IN_COLS, 64 * kb, 32 * nb, F.WIN_T, 32 * nb, nullptr, scr, F.lane); continue; } r -= I_IN;
        if (r < I_OUT) { const int kb = r / 32, nb = r % 32; transpose_item(F.w_out, D_MODEL, D_MODEL, 64 * kb, 32 * nb, F.WOUT_T, 32 * nb, nullptr, scr, F.lane); continue; } r -= I_OUT;
        if (r < I_POOL) { const int g = r / 8, kb = (r % 8) / 4, nb = r % 4; transpose_item(F.w_pool + (size_t)g * 128 * 128, 128, 128, 64 * kb, 32 * nb, F.WP_T + (size_t)g * 128 * 128, 32 * nb, nullptr, scr, F.lane); continue; } r -= I_POOL;
        { const int kb = r / 2, nb = r % 2; transpose_item(F.w_router, D_MODEL, N_EXP, 64 * kb, 32 * nb, F.WR_HI, 32 * nb, F.WR_LO, scr, F.lane); }
    }
    const size_t gt = (size_t)F.vcu * NTHREADS + F.tid, NT = (size_t)F.G * NTHREADS;
    for (size_t i = gt; i < (size_t)T_TOK * D_MODEL / 8; i += NT) {
        const f32x4 a = ld4(F.x + i * 8), b = ld4(F.x + i * 8 + 4);
        u32x4 o; o.x = cvt_pk_bf16(a.x, a.y); o.y = cvt_pk_bf16(a.z, a.w); o.z = cvt_pk_bf16(b.x, b.y); o.w = cvt_pk_bf16(b.z, b.w);
        *(u32x4*)(F.XB + i * 8) = o;
    }
    if (gt < HG_W) { const float a = F.lb_logits[gt], b = F.lb_logits[HG_W + gt], m = fmaxf(a, b); const float ea = expf(a - m), eb = expf(b - m); F.LB[gt] = ea / (ea + eb); }
}

struct DenseSched {
    int nM, nN, nwg, G, c, K; const char* Bt;
    __device__ void init(int M, int N, int K_, const void* Bt_, int G_, int c_) { nM = M / 256; nN = N / 256; nwg = nM * nN; G = G_; c = c_; K = K_; Bt = (const char*)Bt_; }
    __device__ __forceinline__ bool next(int i, pg8::Unit& u) const {
        const long L = (long)i * G + c; if (L >= nwg) return false;
        int wgid = (int)L; { const int q = nwg / pg8::NXCD, r = nwg % pg8::NXCD, xcd = wgid % pg8::NXCD, off = wgid / pg8::NXCD; wgid = (xcd < r ? xcd * (q + 1) : r * (q + 1) + (xcd - r) * q) + off; }
        const int nig = pg8::WGM * nN, gid = wgid / nig, fm = gid * pg8::WGM, gsz = (nM - fm) < pg8::WGM ? (nM - fm) : pg8::WGM;
        u.pm = fm + ((wgid % nig) % gsz); u.pn = (wgid % nig) / gsz; u.g = 0; return true;
    }
    __device__ __forceinline__ void rowsA(const pg8::Unit& u, const int (&Rs)[2], const int (&Cs)[2], unsigned (&v)[2][2]) const {
#pragma unroll
        for (int h = 0; h < 2; ++h)
#pragma unroll
            for (int i = 0; i < 2; ++i) v[h][i] = (unsigned)((u.pm * 256 + h * 128 + Rs[i]) * K + Cs[i]) * 2u;
    }
    __device__ __forceinline__ const char* ptrB(const pg8::Unit& u) const { return Bt + (size_t)u.pn * 256 * K * 2; }
};

__device__ __forceinline__ void build_tables(Frame& F) {
    LAS unsigned* cnt = (LAS unsigned*)(F.lds + TAB_CNT); LAS unsigned* tbase = (LAS unsigned*)(F.lds + TAB_TBASE); LAS unsigned* cbase = (LAS unsigned*)(F.lds + TAB_CBASE);
    LAS unsigned char* t2g = (LAS unsigned char*)(F.lds + TAB_T2G);
    __syncthreads();
    if (F.tid < NGROUP) { const int e = F.tid % 65; unsigned c = (e == 64) ? (unsigned)GCAP : __hip_atomic_load(F.ctl + CW_GCOUNT + F.tid, RLX_AGENT); if (c > (unsigned)GCAP) c = GCAP; cnt[F.tid] = c; }
    __syncthreads();
    if (F.tid == 0) {
        unsigned tb = 0, cb = 0;
        for (int g = 0; g < NGROUP; ++g) { if (g == 65) cb = 0; tbase[g] = tb; cbase[g] = cb; const unsigned c = cnt[g]; tb += (c + 255u) >> 8; if (g % 65 != 64) cb += c; }
        tbase[NGROUP] = tb;
    }
    __syncthreads();
    const unsigned NT = tbase[NGROUP];
    for (unsigned rt = F.tid; rt < NT; rt += NTHREADS) { int lo = 0, hi = NGROUP - 1;
        while (lo < hi) { const int mid = (lo + hi + 1) >> 1; if (tbase[mid] <= rt) lo = mid; else hi = mid - 1; }
        t2g[rt] = (unsigned char)lo; }
    __syncthreads();
}
struct GateUpSched {
    LAS unsigned char* lds; const int* list; const char* Wgu; int G, c; unsigned NU;
    __device__ __forceinline__ bool next(int i, pg8::Unit& u) const {
        const unsigned L = (unsigned)i * G + c; if (L >= NU) return false;
        u.pm = (int)(L >> 1); u.pn = (int)(L & 1u); u.g = ((LAS unsigned char*)(lds + TAB_T2G))[u.pm]; return true;
    }
    __device__ __forceinline__ void rowsA(const pg8::Unit& u, const int (&Rs)[2], const int (&Cs)[2], unsigned (&v)[2][2]) const {
        const unsigned tb = ((LAS unsigned*)(lds + TAB_TBASE))[u.g], cn = ((LAS unsigned*)(lds + TAB_CNT))[u.g]; const int e = u.g % 65, half = u.g / 65;
#pragma unroll
        for (int h = 0; h < 2; ++h)
#pragma unroll
            for (int i = 0; i < 2; ++i) { const unsigned slot = ((unsigned)u.pm - tb) * 256u + h * 128 + Rs[i];
                unsigned tok = 0; if (slot < cn) tok = (e == 64) ? (unsigned)(half * HALF_TOK) + slot : (unsigned)list[(size_t)u.g * GCAP + slot];
                v[h][i] = (tok * D_MODEL + Cs[i]) * 2u; }
    }
    __device__ __forceinline__ const char* ptrB(const pg8::Unit& u) const { return Wgu + ((size_t)(u.g % 65) * 512 + (size_t)u.pn * 256) * D_MODEL * 2; }
};
struct DownSched {
    LAS unsigned char* lds; const char* Wd; int G, c; unsigned rt0, NU;
    __device__ __forceinline__ bool next(int i, pg8::Unit& u) const {
        const unsigned L = (unsigned)i * G + c; if (L >= NU) return false;
        u.pm = (int)(rt0 + (L >> 2)); u.pn = (int)(L & 3u); u.g = ((LAS unsigned char*)(lds + TAB_T2G))[u.pm]; return true;
    }
    __device__ __forceinline__ void rowsA(const pg8::Unit& u, const int (&Rs)[2], const int (&Cs)[2], unsigned (&v)[2][2]) const {
#pragma unroll
        for (int h = 0; h < 2; ++h)
#pragma unroll
            for (int i = 0; i < 2; ++i) v[h][i] = (unsigned)((u.pm * 256 + h * 128 + Rs[i]) * D_EXP + Cs[i]) * 2u;
    }
    __device__ __forceinline__ const char* ptrB(const pg8::Unit& u) const { return Wd + ((size_t)(u.g % 65) * D_MODEL + (size_t)u.pn * 256) * D_EXP * 2; }
};

struct EpiInProj {
    static constexpr bool PERM = true;
    bf16_t *Q, *V, *GS, *UU; float* LOGF; const float* LB;
    __device__ __forceinline__ void operator()(const f32x4 (&acc)[2][2][4][2], const pg8::Unit& u, int wr, int wc, int fr, int fq) const {
        const int sec = u.pn >> 1, row0 = u.pm * 256 + wr * 64 + fr, cs0 = (u.pn & 1) * 256 + wc * 32 + 8 * fq;
        if (sec == 1) {
#pragma unroll
            for (int bj = 0; bj < 2; ++bj) { const f32x4 l0 = ld4(LB + cs0 + bj * 128), l1 = ld4(LB + cs0 + bj * 128 + 4);
#pragma unroll
                for (int ai = 0; ai < 2; ++ai)
#pragma unroll
                    for (int m = 0; m < 4; ++m) { float* p = LOGF + (size_t)(row0 + ai * 128 + m * 16) * 512 + cs0 + bj * 128; const f32x4 a = acc[ai][bj][m][0], b = acc[ai][bj][m][1]; f32x4 o0, o1;
#pragma unroll
                        for (int j = 0; j < 4; ++j) { o0[j] = __logf(l0[j] + (1.0f - l0[j]) * sigmoidf_(a[j])); o1[j] = __logf(l1[j] + (1.0f - l1[j]) * sigmoidf_(b[j])); }
                        *(f32x4*)p = o0; *(f32x4*)(p + 4) = o1; } }
        } else {
            bf16_t* base = sec == 0 ? Q : sec == 2 ? V : sec == 3 ? GS : UU; const bool act = (sec == 0 || sec == 3);
#pragma unroll
            for (int ai = 0; ai < 2; ++ai)
#pragma unroll
                for (int m = 0; m < 4; ++m)
#pragma unroll
                    for (int bj = 0; bj < 2; ++bj) { f32x4 a = acc[ai][bj][m][0], b = acc[ai][bj][m][1];
                        if (act) {
#pragma unroll
                            for (int j = 0; j < 4; ++j) { a[j] = siluf_(a[j]); b[j] = siluf_(b[j]); } }
                        u32x4 w; w.x = cvt_pk_bf16(a[0], a[1]); w.y = cvt_pk_bf16(a[2], a[3]); w.z = cvt_pk_bf16(b[0], b[1]); w.w = cvt_pk_bf16(b[2], b[3]);
                        *(u32x4*)(base + (size_t)(row0 + ai * 128 + m * 16) * 512 + cs0 + bj * 128) = w; }
        }
    }
};
struct EpiOutProj {
    static constexpr bool PERM = false;
    const float* X; float* Y;
    __device__ __forceinline__ void operator()(const f32x4 (&acc)[2][2][4][2], const pg8::Unit& u, int wr, int wc, int fr, int fq) const {
        const int row0 = u.pm * 256 + wr * 64 + fr, col0 = u.pn * 256 + wc * 32 + 4 * fq;
#pragma unroll
        for (int ai = 0; ai < 2; ++ai)
#pragma unroll
            for (int m = 0; m < 4; ++m) { const size_t off = (size_t)(row0 + ai * 128 + m * 16) * D_MODEL + col0;
#pragma unroll
                for (int bj = 0; bj < 2; ++bj)
#pragma unroll
                    for (int n = 0; n < 2; ++n) { const f32x4 xv = ld4(X + off + bj * 128 + n * 16); *(f32x4*)(Y + off + bj * 128 + n * 16) = xv * DN_ALPHA + acc[ai][bj][m][n]; } }
    }
};
struct EpiGateUp {
    static constexpr bool PERM = true;
    bf16_t* ACT;
    __device__ __forceinline__ void operator()(const f32x4 (&acc)[2][2][4][2], const pg8::Unit& u, int wr, int wc, int fr, int fq) const {
        const int row0 = u.pm * 256 + wr * 64 + fr, c0 = u.pn * 128 + wc * 32 + 8 * fq;
#pragma unroll
        for (int ai = 0; ai < 2; ++ai)
#pragma unroll
            for (int m = 0; m < 4; ++m) { const f32x4 g0 = acc[ai][0][m][0], g1 = acc[ai][0][m][1], u0 = acc[ai][1][m][0], u1 = acc[ai][1][m][1]; float a[8];
#pragma unroll
                for (int j = 0; j < 4; ++j) { a[j] = siluf_(g0[j]) * u0[j]; a[4 + j] = siluf_(g1[j]) * u1[j]; }
                u32x4 w; w.x = cvt_pk_bf16(a[0], a[1]); w.y = cvt_pk_bf16(a[2], a[3]); w.z = cvt_pk_bf16(a[4], a[5]); w.w = cvt_pk_bf16(a[6], a[7]);
                *(u32x4*)(ACT + (size_t)(row0 + ai * 128 + m * 16) * D_EXP + c0) = w; }
    }
};
struct EpiDown {
    static constexpr bool PERM = true;
    LAS unsigned char* lds; bf16_t* YB; float* OUT; const float* wlist;
    __device__ __forceinline__ void operator()(const f32x4 (&acc)[2][2][4][2], const pg8::Unit& u, int wr, int wc, int fr, int fq) const {
        const unsigned tb = ((LAS unsigned*)(lds + TAB_TBASE))[u.g], cn = ((LAS unsigned*)(lds + TAB_CNT))[u.g], cb = ((LAS unsigned*)(lds + TAB_CBASE))[u.g];
        const int e = u.g % 65, half = u.g / 65; const int c0 = u.pn * 256 + wc * 32 + 8 * fq;
        const unsigned slot0 = ((unsigned)u.pm - tb) * 256u + wr * 64 + fr;
        if (e == 64) {
#pragma unroll
            for (int ai = 0; ai < 2; ++ai)
#pragma unroll
                for (int m = 0; m < 4; ++m) { const unsigned slot = slot0 + ai * 128 + m * 16;
                    if (slot < cn) { float* p = OUT + (size_t)(half * HALF_TOK + slot) * D_MODEL + c0;
#pragma unroll
                        for (int bj = 0; bj < 2; ++bj) { f32x4 a = ld4(p + bj * 128), b = ld4(p + bj * 128 + 4); a += acc[ai][bj][m][0]; b += acc[ai][bj][m][1]; *(f32x4*)(p + bj * 128) = a; *(f32x4*)(p + bj * 128 + 4) = b; } }
                    asm volatile("" ::: "memory"); }
        } else {
#pragma unroll
            for (int ai = 0; ai < 2; ++ai)
#pragma unroll
                for (int m = 0; m < 4; ++m) { const unsigned slot = slot0 + ai * 128 + m * 16;
                    if (slot < cn) { const float w = wlist[(size_t)u.g * GCAP + slot]; bf16_t* p = YB + (size_t)(cb + slot) * D_MODEL + c0;
#pragma unroll
                        for (int bj = 0; bj < 2; ++bj) { const f32x4 a = acc[ai][bj][m][0] * w, b = acc[ai][bj][m][1] * w; u32x4 o; o.x = cvt_pk_bf16(a[0], a[1]); o.y = cvt_pk_bf16(a[2], a[3]); o.z = cvt_pk_bf16(b[0], b[1]); o.w = cvt_pk_bf16(b[2], b[3]);
                            *(u32x4*)(p + bj * 128) = o; } }
                    asm volatile("" ::: "memory"); }
        }
    }
};

constexpr int P2_QH = 0, P2_QE = 17408, P2_KH = 34816, P2_VT = 52224, P2_KT = 70656, P2_P = 89088, P2_TOT = 98304, P2_SCL = 100352, P2_RMS = 100864, P2_PL = 0;
constexpr int ROW136 = 272, ROW72 = 144;
__device__ __forceinline__ u32x4 pack8(const float* v) { u32x4 o; o.x = cvt_pk_bf16(v[0], v[1]); o.y = cvt_pk_bf16(v[2], v[3]); o.z = cvt_pk_bf16(v[4], v[5]); o.w = cvt_pk_bf16(v[6], v[7]); return o; }

__device__ __forceinline__ void p2a_item(Frame& F, int item) {
    const int bh = item >> 6, c = item & 63, b = bh >> 2, h = bh & 3, t0 = b * SEQ + c * 64;
    const int j = F.tid >> 7, k = F.tid & 127, l = F.lane, lr = l & 15, lq = l >> 4, w = F.wave;
    LAS unsigned char* L = F.lds; LAS float* tot = (LAS float*)(L + P2_TOT); LAS float* scl = (LAS float*)(L + P2_SCL);
    const size_t g0 = (size_t)(t0 + 16 * j) * 512 + h * 128 + k;
    float lf[16], vv[16], cs[16];
#pragma unroll
    for (int i = 0; i < 16; ++i) { lf[i] = F.LOGF[g0 + (size_t)i * 512]; vv[i] = bf2f(F.V[g0 + (size_t)i * 512]); }
    float run = 0.f;
#pragma unroll
    for (int i = 0; i < 16; ++i) { run += lf[i]; cs[i] = run; }
    tot[j * 128 + k] = run;
    *(LAS u32x4*)(L + P2_VT + k * ROW72 + j * 32) = pack8(vv); *(LAS u32x4*)(L + P2_VT + k * ROW72 + j * 32 + 16) = pack8(vv + 8);
    __syncthreads();
    const float t_0 = tot[k], t_1 = tot[128 + k], t_2 = tot[256 + k], t_3 = tot[384 + k];
    const float pre = (j > 0 ? t_0 : 0.f) + (j > 1 ? t_1 : 0.f) + (j > 2 ? t_2 : 0.f), R = t_0 + t_1, bl = R + t_2 + t_3;
    float kh[16];
#pragma unroll
    for (int i = 0; i < 16; ++i) kh[i] = (1.0f - __expf(lf[i])) * __expf(R - (pre + cs[i]));
    *(LAS u32x4*)(L + P2_KT + k * ROW72 + j * 32) = pack8(kh); *(LAS u32x4*)(L + P2_KT + k * ROW72 + j * 32 + 16) = pack8(kh + 8);
    if (j == 0) { F.GDEC[(size_t)item * 128 + k] = __expf(bl); scl[k] = __expf(bl - R); }
    __syncthreads();
    bf16x8 bfr[2];
#pragma unroll
    for (int ks = 0; ks < 2; ++ks) bfr[ks] = *(const LAS bf16x8*)(L + P2_VT + (16 * w + lr) * ROW72 + ks * 64 + lq * 16);
#pragma unroll
    for (int kb = 0; kb < 8; ++kb) { f32x4 acc = {0.f, 0.f, 0.f, 0.f};
#pragma unroll
        for (int ks = 0; ks < 2; ++ks) { const bf16x8 a = *(const LAS bf16x8*)(L + P2_KT + (16 * kb + lr) * ROW72 + ks * 64 + lq * 16); acc = __builtin_amdgcn_mfma_f32_16x16x32_bf16(a, bfr[ks], acc, 0, 0, 0); }
        const f32x4 sc = *(const LAS f32x4*)(scl + 16 * kb + 4 * lq); acc = acc * sc;
        u32x2 o; o.x = cvt_pk_bf16(acc[0], acc[1]); o.y = cvt_pk_bf16(acc[2], acc[3]);
        *(u32x2*)(F.US + (size_t)item * 16384 + (16 * w + lr) * 128 + 16 * kb + 4 * lq) = o; }
    __syncthreads();
}
__device__ __forceinline__ void p2b_scan(Frame& F) {
    const unsigned gt = (unsigned)F.vcu * NTHREADS + F.tid, NT = (unsigned)F.G * NTHREADS;
    for (unsigned idx = gt; idx < 16u * 8192u; idx += NT) {
        const unsigned bh = idx >> 13, e2 = idx & 8191u, k = (e2 & 63u) * 2u;
        unsigned* us = (unsigned*)F.US + (size_t)bh * 64 * 8192 + e2; const float* gd = F.GDEC + (size_t)bh * 64 * 128 + k;
        float s0 = 0.f, s1 = 0.f;
#pragma unroll 8
        for (int c = 0; c < 64; ++c) { const unsigned u = us[(size_t)c * 8192]; const f32x2 g = *(const f32x2*)(gd + c * 128);
            us[(size_t)c * 8192] = cvt_pk_bf16(s0, s1);
            s0 = g.x * s0 + bf2f(u & 0xffffu); s1 = g.y * s1 + bf2f(u >> 16); }
    }
}
__device__ __forceinline__ void p2c_hgrn_item(Frame& F, int item) {
    const int bh = item >> 6, c = item & 63, b = bh >> 2, h = bh & 3, t0 = b * SEQ + c * 64;
    const int j = F.tid >> 7, k = F.tid & 127, l = F.lane, lr = l & 15, lq = l >> 4, w = F.wave;
    LAS unsigned char* L = F.lds; LAS float* tot = (LAS float*)(L + P2_TOT); LAS float* rms = (LAS float*)(L + P2_RMS);
    const size_t g0 = (size_t)(t0 + 16 * j) * 512 + h * 128 + k;
    float lf[16], vv[16], qq[16], cs[16];
#pragma unroll
    for (int i = 0; i < 16; ++i) { lf[i] = F.LOGF[g0 + (size_t)i * 512]; vv[i] = bf2f(F.V[g0 + (size_t)i * 512]); qq[i] = bf2f(F.Q[g0 + (size_t)i * 512]); }
    float run = 0.f;
#pragma unroll
    for (int i = 0; i < 16; ++i) { run += lf[i]; cs[i] = run; }
    tot[j * 128 + k] = run;
    *(LAS u32x4*)(L + P2_VT + k * ROW72 + j * 32) = pack8(vv); *(LAS u32x4*)(L + P2_VT + k * ROW72 + j * 32 + 16) = pack8(vv + 8);
    __syncthreads();
    const float t_0 = tot[k], t_1 = tot[128 + k], t_2 = tot[256 + k];
    const float pre = (j > 0 ? t_0 : 0.f) + (j > 1 ? t_1 : 0.f) + (j > 2 ? t_2 : 0.f), R = t_0 + t_1;
#pragma unroll
    for (int i = 0; i < 16; ++i) { const float bi = pre + cs[i], ed = __expf(bi - R); const int t = 16 * j + i;
        *(LAS bf16_t*)(L + P2_QH + t * ROW136 + k * 2) = (bf16_t)f2bf(qq[i] * ed);
        *(LAS bf16_t*)(L + P2_QE + t * ROW136 + k * 2) = (bf16_t)f2bf(qq[i] * __expf(bi));
        *(LAS bf16_t*)(L + P2_KH + t * ROW136 + k * 2) = (bf16_t)f2bf((1.0f - __expf(lf[i])) * __expf(R - bi)); }
    __syncthreads();
    {
        const int tb = w >> 1;
        bf16x8 bq[4];
#pragma unroll
        for (int ks = 0; ks < 4; ++ks) bq[ks] = *(const LAS bf16x8*)(L + P2_QH + (16 * tb + lr) * ROW136 + ks * 64 + lq * 16);
#pragma unroll
        for (int x = 0; x < 2; ++x) { const int sb = 2 * (w & 1) + x; f32x4 acc = {0.f, 0.f, 0.f, 0.f};
            if (sb <= tb) {
#pragma unroll
                for (int ks = 0; ks < 4; ++ks) { const bf16x8 a = *(const LAS bf16x8*)(L + P2_KH + (16 * sb + lr) * ROW136 + ks * 64 + lq * 16); acc = __builtin_amdgcn_mfma_f32_16x16x32_bf16(a, bq[ks], acc, 0, 0, 0); } }
            const int t = 16 * tb + lr, s = 16 * sb + 4 * lq;
#pragma unroll
            for (int r = 0; r < 4; ++r) if (s + r > t) acc[r] = 0.f;
            u32x2 o; o.x = cvt_pk_bf16(acc[0], acc[1]); o.y = cvt_pk_bf16(acc[2], acc[3]);
            *(LAS u32x2*)(L + P2_P + t * ROW72 + s * 2) = o; }
    }
    __syncthreads();
    const int tb = w & 3, vg = w >> 2, t = 16 * tb + lr;
    f32x4 o4[4];
    {
        bf16x8 bp[2], bq[4];
#pragma unroll
        for (int ks = 0; ks < 2; ++ks) bp[ks] = *(const LAS bf16x8*)(L + P2_P + t * ROW72 + ks * 64 + lq * 16);
#pragma unroll
        for (int ks = 0; ks < 4; ++ks) bq[ks] = *(const LAS bf16x8*)(L + P2_QE + t * ROW136 + ks * 64 + lq * 16);
#pragma unroll
        for (int x = 0; x < 4; ++x) { const int vb = 4 * vg + x; f32x4 acc = {0.f, 0.f, 0.f, 0.f};
#pragma unroll
            for (int ks = 0; ks < 2; ++ks) { const bf16x8 a = *(const LAS bf16x8*)(L + P2_VT + (16 * vb + lr) * ROW72 + ks * 64 + lq * 16); acc = __builtin_amdgcn_mfma_f32_16x16x32_bf16(a, bp[ks], acc, 0, 0, 0); }
#pragma unroll
            for (int ks = 0; ks < 4; ++ks) { const bf16x8 a = *(const bf16x8*)(F.US + (size_t)item * 16384 + (16 * vb + lr) * 128 + ks * 32 + lq * 8); acc = __builtin_amdgcn_mfma_f32_16x16x32_bf16(a, bq[ks], acc, 0, 0, 0); }
            o4[x] = acc; }
    }
    float ss = 0.f;
#pragma unroll
    for (int x = 0; x < 4; ++x)
#pragma unroll
        for (int r = 0; r < 4; ++r) ss += o4[x][r] * o4[x][r];
    ss += __shfl_xor(ss, 16); ss += __shfl_xor(ss, 32);
    if (lq == 0) rms[vg * 64 + t] = ss;
    __syncthreads();
    const float rstd = 1.0f / sqrtf((rms[t] + rms[64 + t]) * (1.0f / 128.0f) + RMS_EPS);
#pragma unroll
    for (int x = 0; x < 4; ++x) { const int v = 16 * (4 * vg + x) + 4 * lq;
        const u32x2 gs = *(const u32x2*)(F.GS + (size_t)(t0 + t) * 512 + h * 128 + v); const f32x4 ng = ld4(F.hg_norm_g + h * 128 + v);
        const float a0 = o4[x][0] * rstd * ng[0] * bf2f(gs.x & 0xffffu), a1 = o4[x][1] * rstd * ng[1] * bf2f(gs.x >> 16), a2 = o4[x][2] * rstd * ng[2] * bf2f(gs.y & 0xffffu), a3 = o4[x][3] * rstd * ng[3] * bf2f(gs.y >> 16);
        u32x2 o; o.x = cvt_pk_bf16(a0, a1); o.y = cvt_pk_bf16(a2, a3);
        *(u32x2*)(F.MIX + (size_t)(t0 + t) * D_MODEL + h * 128 + v) = o; }
    __syncthreads();
}
template <int W>
__device__ __forceinline__ void pool_fill(Frame& F, int b, int tile, int g) {
    const int j = F.tid >> 7, c = F.tid & 127, pos0 = tile * 64 + 16 * j;
    float uu[31];
#pragma unroll
    for (int m = 0; m < 31; ++m) { const int pos = pos0 - 15 + m; uu[m] = (m >= 16 - W && pos >= 0) ? bf2f(F.UU[(size_t)(b * SEQ + pos) * 512 + g * 128 + c]) : 0.f; }
#pragma unroll
    for (int i = 0; i < 16; ++i) { float s = 0.f;
#pragma unroll
        for (int r = 0; r < W; ++r) s += uu[15 + i - r];
        const int pos = pos0 + i; const float cnt = (float)(pos + 1 < W ? pos + 1 : W);
        *(LAS bf16_t*)(F.lds + P2_PL + (16 * j + i) * ROW136 + c * 2) = (bf16_t)f2bf(s / cnt - uu[15 + i]); }
}
__device__ __forceinline__ void p2c_pool_item(Frame& F, int item) {
    const int g = item & 3, tile = (item >> 2) & 63, b = item >> 8, t0 = b * SEQ + tile * 64;
    const int l = F.lane, lr = l & 15, lq = l >> 4, w = F.wave;
    if (g == 0) pool_fill<2>(F, b, tile, g); else if (g == 1) pool_fill<4>(F, b, tile, g); else if (g == 2) pool_fill<8>(F, b, tile, g); else pool_fill<16>(F, b, tile, g);
    __syncthreads();
    const int tb = w & 3, dg = w >> 2, t = 16 * tb + lr;
    bf16x8 bfr[4];
#pragma unroll
    for (int ks = 0; ks < 4; ++ks) bfr[ks] = *(const LAS bf16x8*)(F.lds + P2_PL + t * ROW136 + ks * 64 + lq * 16);
#pragma unroll
    for (int x = 0; x < 4; ++x) { const int db = 4 * dg + x; f32x4 acc = {0.f, 0.f, 0.f, 0.f};
#pragma unroll
        for (int ks = 0; ks < 4; ++ks) { const bf16x8 a = *(const bf16x8*)(F.WP_T + (size_t)g * 16384 + (16 * db + lr) * 128 + ks * 32 + lq * 8); acc = __builtin_amdgcn_mfma_f32_16x16x32_bf16(a, bfr[ks], acc, 0, 0, 0); }
        const int d = 16 * db + 4 * lq; const f32x4 ps = ld4(F.pool_scale + g * 128 + d); acc = acc * ps;
        u32x2 o; o.x = cvt_pk_bf16(acc[0], acc[1]); o.y = cvt_pk_bf16(acc[2], acc[3]);
        *(u32x2*)(F.MIX + (size_t)(t0 + t) * D_MODEL + 512 + g * 128 + d) = o; }
    __syncthreads();
}

constexpr int P4_ROWB = 2064, P4_HHI = 0, P4_HLO = 32 * P4_ROWB, P4_LGO = 64 * P4_ROWB;
constexpr int P4_CNT = P4_LGO + 8320, P4_BASE = P4_CNT + 256;
static_assert(P4_BASE + 256 <= LDSCTL_OFF, "P4 LDS map");
__device__ __forceinline__ void p4_route(Frame& F) {
    LAS unsigned char* L = F.lds; LAS float* LG = (LAS float*)(L + P4_LGO); LAS unsigned* lcnt = (LAS unsigned*)(L + P4_CNT); LAS unsigned* lbase = (LAS unsigned*)(L + P4_BASE);
    const int l = F.lane, lr = l & 15, lq = l >> 4, w = F.wave;
    for (int tile = F.vcu; tile < T_TOK / 32; tile += F.G) {
        const int t0 = tile * 32;
        if (F.tid < 64) lcnt[F.tid] = 0u;
#pragma unroll 1
        for (int rr = 0; rr < 4; ++rr) { const int row = 4 * w + rr; float* y = F.out + (size_t)(t0 + row) * D_MODEL;
            f32x4 v[4]; float s = 0.f;
#pragma unroll
            for (int jj = 0; jj < 4; ++jj) { v[jj] = ld4(y + 4 * l + 256 * jj); s += (v[jj][0] + v[jj][1]) + (v[jj][2] + v[jj][3]); }
            const float mu = wave_sum(s) * (1.0f / D_MODEL); float q = 0.f;
#pragma unroll
            for (int jj = 0; jj < 4; ++jj) { v[jj] = v[jj] - mu; q += (v[jj][0] * v[jj][0] + v[jj][1] * v[jj][1]) + (v[jj][2] * v[jj][2] + v[jj][3] * v[jj][3]); }
            const float rstd = 1.0f / sqrtf(wave_sum(q) * (1.0f / D_MODEL) + LN_EPS);
#pragma unroll
            for (int jj = 0; jj < 4; ++jj) { const int cc = 4 * l + 256 * jj; const f32x4 g = ld4(F.ln1_g + cc), bb = ld4(F.ln1_b + cc); const f32x4 hh = v[jj] * rstd * g + bb;
                *(f32x4*)(y + cc) = hh * DN_ALPHA;
                const unsigned h0 = f2bf(hh[0]), h1 = f2bf(hh[1]), h2 = f2bf(hh[2]), h3 = f2bf(hh[3]);
                u32x2 hi; hi.x = h0 | (h1 << 16); hi.y = h2 | (h3 << 16);
                u32x2 lo; lo.x = cvt_pk_bf16(hh[0] - bf2f(h0), hh[1] - bf2f(h1)); lo.y = cvt_pk_bf16(hh[2] - bf2f(h2), hh[3] - bf2f(h3));
                *(u32x2*)(F.HB + (size_t)(t0 + row) * D_MODEL + cc) = hi;
                *(LAS u32x2*)(L + P4_HHI + row * P4_ROWB + cc * 2) = hi; *(LAS u32x2*)(L + P4_HLO + row * P4_ROWB + cc * 2) = lo; } }
        __syncthreads();
        {
            const int tb = w & 1, eb = w >> 1; f32x4 acc = {0.f, 0.f, 0.f, 0.f};
            const bf16_t* ah = F.WR_HI + (size_t)(16 * eb + lr) * D_MODEL + lq * 8; const bf16_t* al = F.WR_LO + (size_t)(16 * eb + lr) * D_MODEL + lq * 8;
#pragma unroll 4
            for (int ks = 0; ks < 32; ++ks) { const bf16x8 a_h = *(const bf16x8*)(ah + ks * 32), a_l = *(const bf16x8*)(al + ks * 32);
                const bf16x8 b_h = *(const LAS bf16x8*)(L + P4_HHI + (16 * tb + lr) * P4_ROWB + ks * 64 + lq * 16), b_l = *(const LAS bf16x8*)(L + P4_HLO + (16 * tb + lr) * P4_ROWB + ks * 64 + lq * 16);
                acc = __builtin_amdgcn_mfma_f32_16x16x32_bf16(a_h, b_h, acc, 0, 0, 0); acc = __builtin_amdgcn_mfma_f32_16x16x32_bf16(a_l, b_h, acc, 0, 0, 0); acc = __builtin_amdgcn_mfma_f32_16x16x32_bf16(a_h, b_l, acc, 0, 0, 0); }
#pragma unroll
            for (int r = 0; r < 4; ++r) LG[(16 * tb + lr) * 65 + 16 * eb + 4 * lq + r] = acc[r];
        }
        __syncthreads();
        int erk4[4]; unsigned lrk4[4]; float wgt4[4]; bool ch4[4];
        const float rbias = F.router_bias[l];
#pragma unroll
        for (int rr = 0; rr < 4; ++rr) { const int row = 4 * w + rr;
            const float lg = LG[row * 65 + l], score = 1.0f / (1.0f + expf(-lg)), sel = score + rbias;
            int rk = 0;
#pragma unroll
            for (int o = 1; o < 8; ++o) { const int src = (l & ~7) | ((l + o) & 7); const float xx = __shfl(sel, src); rk += (xx > sel || (xx == sel && src < l)) ? 1 : 0; }
            float gsum = rk < 2 ? sel : 0.f;
            gsum += __shfl_xor(gsum, 1); gsum += __shfl_xor(gsum, 2); gsum += __shfl_xor(gsum, 4);
            const int grp = l >> 3; int grk = 0;
#pragma unroll
            for (int o = 1; o < 8; ++o) { const int sg = (grp + o) & 7; const float xx = __shfl(gsum, sg * 8); grk += (xx > gsum || (xx == gsum && sg < grp)) ? 1 : 0; }
            const bool gsel = grk < 4; const float msel = gsel ? sel : -INFINITY; int erk = 0;
#pragma unroll 9
            for (int o = 1; o < 64; ++o) { const int src = (l + o) & 63; const float xx = __shfl(msel, src); erk += (xx > msel || (xx == msel && src < l)) ? 1 : 0; }
            const bool chosen = gsel && erk < 8; const float wsum = wave_sum(chosen ? score : 0.f);
            ch4[rr] = chosen; erk4[rr] = erk; wgt4[rr] = score / wsum * ROUTED_SCALE;
            lrk4[rr] = chosen ? __hip_atomic_fetch_add(lcnt + l, 1u, __ATOMIC_RELAXED, __HIP_MEMORY_SCOPE_WORKGROUP) : 0u; }
        __syncthreads();
        const int half = t0 >= HALF_TOK ? 1 : 0;
        if (F.tid < 64) { const unsigned c = lcnt[F.tid]; lbase[F.tid] = c ? __hip_atomic_fetch_add(F.ctl + CW_GCOUNT + half * 65 + F.tid, c, RLX_AGENT) : 0u; }
        __syncthreads();
#pragma unroll
        for (int rr = 0; rr < 4; ++rr) if (ch4[rr]) { const int t = t0 + 4 * w + rr; const unsigned slot = lbase[l] + lrk4[rr]; const int grpid = half * 65 + l;
            F.asg_e[t * 8 + erk4[rr]] = l; F.asg_w[t * 8 + erk4[rr]] = wgt4[rr]; F.asg_s[t * 8 + erk4[rr]] = (int)slot;
            if (slot < (unsigned)GCAP) { F.list[(size_t)grpid * GCAP + slot] = t; F.wlist[(size_t)grpid * GCAP + slot] = wgt4[rr]; } }
        __syncthreads();
    }
}
__device__ __forceinline__ void p4_convert(Frame& F) {
    LAS float* scr = (LAS float*)(F.lds + F.wave * 16384);
    const int gw = F.vcu * NWAVES + F.wave, NGW = F.G * NWAVES;
    for (int it = gw; it < 65 * 3 * 128; it += NGW) {
        const int r = it & 127, em = it >> 7, e = em / 3, mat = em % 3;
        if (mat < 2) { const float* W = e < 64 ? (mat == 0 ? F.w_gate : F.w_up) + (size_t)e * D_MODEL * D_EXP : (mat == 0 ? F.ws_gate : F.ws_up);
            const int kb = r >> 3, nb = r & 7, n0 = 32 * nb; transpose_item(W, D_MODEL, D_EXP, 64 * kb, n0, F.WGU_T + (size_t)e * 512 * D_MODEL, (n0 >> 7) * 256 + mat * 128 + (n0 & 127), nullptr, scr, F.lane); }
        else { const float* W = e < 64 ? F.w_down + (size_t)e * D_EXP * D_MODEL : F.ws_down; const int kb = r >> 5, nb = r & 31;
            transpose_item(W, D_EXP, D_MODEL, 64 * kb, 32 * nb, F.WD_T + (size_t)e * D_MODEL * D_EXP, 32 * nb, nullptr, scr, F.lane); }
    }
}

__device__ __forceinline__ void p7_combine(Frame& F, int half) {
    const LAS unsigned* cbase = (const LAS unsigned*)(F.lds + TAB_CBASE); const int l = F.lane;
    for (int tl = F.vcu * NWAVES + F.wave; tl < HALF_TOK; tl += F.G * NWAVES) { const int t = half * HALF_TOK + tl; float* y = F.out + (size_t)t * D_MODEL;
        float a[16];
        { const f32x4 p0 = ld4(y + 8 * l), p1 = ld4(y + 8 * l + 4), p2 = ld4(y + 512 + 8 * l), p3 = ld4(y + 512 + 8 * l + 4);
#pragma unroll
          for (int q = 0; q < 4; ++q) { a[q] = p0[q]; a[4 + q] = p1[q]; a[8 + q] = p2[q]; a[12 + q] = p3[q]; } }
#pragma unroll
        for (int k = 0; k < 8; ++k) { const int e = F.asg_e[t * 8 + k], s = F.asg_s[t * 8 + k]; const size_t row = (size_t)cbase[half * 65 + e] + (unsigned)s;
            const u32x4 r0 = *(const u32x4*)(F.YB + row * D_MODEL + 8 * l), r1 = *(const u32x4*)(F.YB + row * D_MODEL + 512 + 8 * l);
#pragma unroll
            for (int q = 0; q < 4; ++q) { a[2 * q] += bf2f(r0[q] & 0xffffu); a[2 * q + 1] += bf2f(r0[q] >> 16); a[8 + 2 * q] += bf2f(r1[q] & 0xffffu); a[8 + 2 * q + 1] += bf2f(r1[q] >> 16); } }
        float s = 0.f;
#pragma unroll
        for (int q = 0; q < 16; ++q) s += a[q];
        const float mu = wave_sum(s) * (1.0f / D_MODEL); float qv = 0.f;
#pragma unroll
        for (int q = 0; q < 16; ++q) { a[q] -= mu; qv += a[q] * a[q]; }
        const float rstd = 1.0f / sqrtf(wave_sum(qv) * (1.0f / D_MODEL) + LN_EPS);
#pragma unroll
        for (int hh = 0; hh < 2; ++hh)
#pragma unroll
            for (int q4 = 0; q4 < 2; ++q4) { const int cc = hh * 512 + 8 * l + 4 * q4; const f32x4 g = ld4(F.ln2_g + cc), bb = ld4(F.ln2_b + cc); f32x4 o;
#pragma unroll
                for (int q = 0; q < 4; ++q) o[q] = a[hh * 8 + q4 * 4 + q] * rstd * g[q] + bb[q];
                *(f32x4*)(y + cc) = o; }
    }
}

constexpr int N_PHASES = 12;
__global__ void __launch_bounds__(NTHREADS, 2) mk_fwd(Args args) {
    extern __shared__ __attribute__((aligned(16))) unsigned char lds[];
    Frame F;
    F.lds = (LAS unsigned char*)lds; F.tid = threadIdx.x; F.lane = F.tid & 63; F.wave = __builtin_amdgcn_readfirstlane(F.tid >> 6);
    F.G = gridDim.x; { const int bx = blockIdx.x; F.vcu = (F.G % 8 == 0) ? (bx % 8) * (F.G / 8) + bx / 8 : bx; }
    unsigned char* ws = args.ws; F.ws = ws; F.ctl = (gu32*)(ws + WS_CTL); F.out = args.out;
    F.x = args.in[0]; F.w_in = args.in[1]; F.lb_logits = args.in[2]; F.hg_norm_g = args.in[3]; F.w_pool = args.in[4]; F.pool_scale = args.in[5]; F.w_out = args.in[6];
    F.ln1_g = args.in[7]; F.ln1_b = args.in[8]; F.w_router = args.in[9]; F.router_bias = args.in[10]; F.w_gate = args.in[11]; F.w_up = args.in[12]; F.w_down = args.in[13];
    F.ws_gate = args.in[14]; F.ws_up = args.in[15]; F.ws_down = args.in[16]; F.ln2_g = args.in[17]; F.ln2_b = args.in[18];
    F.LB = (float*)(ws + WS_SMALL); F.GDEC = (float*)(ws + WS_GDEC); F.WP_T = (bf16_t*)(ws + WS_WP_T); F.WR_HI = (bf16_t*)(ws + WS_WR_HI); F.WR_LO = (bf16_t*)(ws + WS_WR_LO);
    F.WIN_T = (bf16_t*)(ws + WS_WIN_T); F.WOUT_T = (bf16_t*)(ws + WS_WOUT_T); F.XB = (bf16_t*)(ws + WS_XB); F.US = (bf16_t*)(ws + WS_US);
    F.Q = (bf16_t*)(ws + WS_Q); F.V = (bf16_t*)(ws + WS_V); F.GS = (bf16_t*)(ws + WS_GS); F.UU = (bf16_t*)(ws + WS_UU); F.LOGF = (float*)(ws + WS_LOGF); F.MIX = (bf16_t*)(ws + WS_MIX);
    F.WD_T = (bf16_t*)(ws + WS_WD_T); F.ACT = (bf16_t*)(ws + WS_ACT); F.YB = (bf16_t*)(ws + WS_YB); F.WGU_T = (bf16_t*)(ws + WS_WGU_T); F.HB = (bf16_t*)(ws + WS_HB);
    F.asg_e = (int*)(ws + WS_ROUTE + RT_ASG_E); F.asg_w = (float*)(ws + WS_ROUTE + RT_ASG_W); F.asg_s = (int*)(ws + WS_ROUTE + RT_ASG_S); F.list = (int*)(ws + WS_ROUTE + RT_LIST); F.wlist = (float*)(ws + WS_ROUTE + RT_WLIST);
    for (int u = F.tid; u < (LDS_BYTES - LDSCTL_OFF) / 4; u += NTHREADS) ((LAS unsigned*)(F.lds + LDSCTL_OFF))[u] = 0u;
    __syncthreads();
    const int lo = args.ph_lo, hi = args.ph_hi;
    XcdBarrier bar; bar.bar = (unsigned*)(F.ctl + CW_BAR); bar.x = 0; bar.st = nullptr;
    if (hi - lo > 1) bar = xcd_barrier_post((unsigned*)(F.ctl + CW_BAR), (volatile LAS unsigned*)(F.lds + MISC_OFF) + 8);
#ifndef PH_MASK
#define PH_MASK 0xFFF
#endif
#define IN(k) (((PH_MASK >> (k)) & 1) && lo <= (k) && (k) < hi)
#define SEAM(k) do { if (IN(k) && IN((k) + 1)) xcd_barrier(bar); } while (0)

    if (IN(0)) { p0_prep(F); SEAM(0); }
    if (IN(1)) { DenseSched S; S.init(T_TOK, IN_COLS, D_MODEL, F.WIN_T, F.G, (int)blockIdx.x); EpiInProj E{F.Q, F.V, F.GS, F.UU, F.LOGF, F.LB};
        pg8::gemm_phase<EpiInProj, DenseSched, true>(F.lds, (const char*)F.XB, D_MODEL, S, E); SEAM(1); }
    if (IN(2)) { for (int it = F.vcu; it < 1024; it += F.G) p2a_item(F, it); SEAM(2); }
    if (IN(3)) { p2b_scan(F); SEAM(3); }
    if (IN(4)) { for (int it = F.vcu; it < 2048; it += F.G) { if (it < 1024) p2c_hgrn_item(F, it); else p2c_pool_item(F, it - 1024); } SEAM(4); }
    if (IN(5)) { DenseSched S; S.init(T_TOK, D_MODEL, D_MODEL, F.WOUT_T, F.G, (int)blockIdx.x); EpiOutProj E{F.x, F.out};
        pg8::gemm_phase<EpiOutProj, DenseSched, false>(F.lds, (const char*)F.MIX, D_MODEL, S, E); SEAM(5); }
    if (IN(6)) { if (!(args.flags & 1)) p4_route(F); p4_convert(F); SEAM(6); }
    if (IN(7)) { build_tables(F); GateUpSched S{F.lds, F.list, (const char*)F.WGU_T, F.G, F.vcu, 2u * ((const LAS unsigned*)(F.lds + TAB_TBASE))[NGROUP]}; EpiGateUp E{F.ACT};
        pg8::gemm_phase<EpiGateUp, GateUpSched, true>(F.lds, (const char*)F.HB, D_MODEL, S, E); SEAM(7); }
#pragma unroll 1
    for (int half = 0; half < 2; ++half) {
        const int pd = 8 + 2 * half, pc = 9 + 2 * half;
        if (IN(pd)) { build_tables(F); const LAS unsigned* tbase = (const LAS unsigned*)(F.lds + TAB_TBASE); const unsigned rt0 = tbase[half * 65], rt1 = tbase[half * 65 + 65];
            DownSched S{F.lds, (const char*)F.WD_T, F.G, F.vcu, rt0, 4u * (rt1 - rt0)}; EpiDown E{F.lds, F.YB, F.out, F.wlist};
            pg8::gemm_phase<EpiDown, DownSched, true>(F.lds, (const char*)F.ACT, D_EXP, S, E); SEAM(pd); }
        if (IN(pc)) { build_tables(F); p7_combine(F, half); SEAM(pc); }
    }
#undef IN
#undef SEAM
}
static void launch_phases(const Args& base, int lo, int hi, int grid, hipStream_t stream) {
    Args a = base; a.ph_lo = lo; a.ph_hi = hi;
    hipLaunchKernelGGL(mk_fwd, dim3(grid), dim3(NTHREADS), LDS_BYTES, stream, a);
    const hipError_t le = hipPeekAtLastError();
    if (le != hipSuccess) fprintf(stderr, "kernel_launch: launch of phases [%d,%d) failed: %s\n", lo, hi, hipGetErrorName(le));
}
extern "C" void kernel_launch(void* const* d_in, const int* in_sizes, int n_in, void* d_out, int out_size, void* d_ws, size_t ws_size, hipStream_t stream) {
    static int grid = 0;
    if (grid == 0) {
        if (n_in != 19 || out_size != T_TOK * D_MODEL || ws_size < WS_NEED) { fprintf(stderr, "kernel_launch: unexpected shapes n_in %d out %d ws %zu (need %zu)\n", n_in, out_size, ws_size, (size_t)WS_NEED); grid = -1; return; }
        int dev = 0, cus = 0, per_cu = 0;
        if (hipGetDevice(&dev) != hipSuccess || hipDeviceGetAttribute(&cus, hipDeviceAttributeMultiprocessorCount, dev) != hipSuccess) { fprintf(stderr, "kernel_launch: device query failed\n"); grid = -1; return; }
        if (hipFuncSetAttribute((const void*)mk_fwd, hipFuncAttributeMaxDynamicSharedMemorySize, LDS_BYTES) != hipSuccess) { fprintf(stderr, "kernel_launch: hipFuncSetAttribute failed\n"); grid = -1; return; }
        if (hipOccupancyMaxActiveBlocksPerMultiprocessor(&per_cu, (const void*)mk_fwd, NTHREADS, LDS_BYTES) != hipSuccess || per_cu < 1) { fprintf(stderr, "kernel_launch: occupancy query says %d blocks per CU; nothing launched\n", per_cu); (void)hipGetLastError(); grid = -1; return; }
        grid = cus;
    }
    if (grid < 0) return;
    const float* x = (const float*)d_in[0]; const float* w_in = (const float*)d_in[1]; const float* lb_logits = (const float*)d_in[2]; const float* hg_norm_g = (const float*)d_in[3];
    const float* w_pool = (const float*)d_in[4]; const float* pool_scale = (const float*)d_in[5]; const float* w_out = (const float*)d_in[6];
    const float* ln1_g = (const float*)d_in[7]; const float* ln1_b = (const float*)d_in[8]; const float* w_router = (const float*)d_in[9]; const float* router_bias = (const float*)d_in[10];
    const float* w_gate = (const float*)d_in[11]; const float* w_up = (const float*)d_in[12]; const float* w_down = (const float*)d_in[13];
    const float* ws_gate = (const float*)d_in[14]; const float* ws_up = (const float*)d_in[15]; const float* ws_down = (const float*)d_in[16];
    const float* ln2_g = (const float*)d_in[17]; const float* ln2_b = (const float*)d_in[18];
    unsigned char* ws = (unsigned char*)d_ws; float* out = (float*)d_out;
    float* lb = (float*)(ws + WS_SMALL);
    bf16_t* Q = (bf16_t*)(ws + WS_Q); bf16_t* V = (bf16_t*)(ws + WS_V); bf16_t* GS = (bf16_t*)(ws + WS_GS); bf16_t* UU = (bf16_t*)(ws + WS_UU);
    float* LOGF = (float*)(ws + WS_LOGF); bf16_t* MIX = (bf16_t*)(ws + WS_MIX); bf16_t* HB = (bf16_t*)(ws + WS_HB);
    float* TMP0 = (float*)(ws + WS_TMP0); float* TMP1 = (float*)(ws + WS_TMP1);
    int* asg_e = (int*)(ws + WS_ROUTE + RT_ASG_E); float* asg_w = (float*)(ws + WS_ROUTE + RT_ASG_W); int* asg_s = (int*)(ws + WS_ROUTE + RT_ASG_S); int* list = (int*)(ws + WS_ROUTE + RT_LIST); float* wlist = (float*)(ws + WS_ROUTE + RT_WLIST);
    unsigned* ctl = (unsigned*)(ws + WS_CTL);
    if (hipMemsetAsync(ws + WS_CTL, 0, 1 * MiB, stream) != hipSuccess) { fprintf(stderr, "kernel_launch: memset failed\n"); return; }
    Args a{};
    for (int i = 0; i < 19; ++i) a.in[i] = (const float*)d_in[i];
    a.out = out; a.ws = ws;
#if FUSED
    static_assert(!FUSED || OPT_MASK == 0x1F, "the one-launch build needs every stage optimized");
    launch_phases(a, 0, N_PHASES, grid, stream);
#else
    const int NE = (int)(((size_t)T_TOK * 512 + 255) / 256);
    if (OPT_MASK) launch_phases(a, 0, 1, grid, stream);
    else nv_lb<<<2, 256, 0, stream>>>(lb_logits, lb);
    if (OPT_MASK & 1) launch_phases(a, 1, 2, grid, stream);
    else for (int sec = 0; sec < 5; ++sec) {
        nv_gemm<false><<<dim3(512 / 64, T_TOK / 64), 256, 0, stream>>>(x, D_MODEL, w_in + sec * 512, IN_COLS, TMP0, 512, T_TOK, 512, D_MODEL, nullptr, 0.f);
        nv_act<<<NE, 256, 0, stream>>>(TMP0, sec, lb, Q, LOGF, V, GS, UU);
    }
    if (OPT_MASK & 2) { launch_phases(a, 2, 3, grid, stream); launch_phases(a, 3, 4, grid, stream); launch_phases(a, 4, 5, grid, stream); }
    else {
        nv_hgrn<<<BATCH * HG_H, 128, 0, stream>>>(Q, LOGF, V, TMP0);
        nv_hgnorm<<<T_TOK * HG_H / 4, 256, 0, stream>>>(TMP0, hg_norm_g, GS, MIX);
        nv_pool<<<NE, 256, 0, stream>>>(UU, TMP1);
        for (int g = 0; g < POOL_G; ++g)
            nv_gemm<false><<<dim3(128 / 64, T_TOK / 64), 256, 0, stream>>>(TMP1 + g * 128, 512, w_pool + (size_t)g * 128 * 128, 128, TMP0 + g * 128, 512, T_TOK, 128, 128, nullptr, 0.f);
        nv_poolout<<<NE, 256, 0, stream>>>(TMP0, pool_scale, MIX);
    }
    if (OPT_MASK & 4) launch_phases(a, 5, 6, grid, stream);
    else nv_gemm<true><<<dim3(D_MODEL / 64, T_TOK / 64), 256, 0, stream>>>(MIX, D_MODEL, w_out, D_MODEL, out, D_MODEL, T_TOK, D_MODEL, D_MODEL, x, DN_ALPHA);
    if (OPT_MASK & 8) launch_phases(a, 6, 7, grid, stream);
    else { nv_ln_route<<<T_TOK, 64, 0, stream>>>(out, ln1_g, ln1_b, w_router, router_bias, HB, asg_e, asg_w, asg_s, list, wlist, ctl + CW_GCOUNT);
        if (OPT_MASK & 16) { Args b = a; b.flags = 1; launch_phases(b, 6, 7, grid, stream); } }
    if (OPT_MASK & 16) { for (int p = 7; p < N_PHASES; ++p) launch_phases(a, p, p + 1, grid, stream); }
    else nv_moe<<<T_TOK, 256, 0, stream>>>(out, asg_e, asg_w, w_gate, w_up, w_down, ws_gate, ws_up, ws_down, ln2_g, ln2_b);
#endif
}
```
